# Optimizing an MI355X kernel written in HIP

```python
import functools
import jax, jax.numpy as jnp
from jax import lax
import numpy as np


D_MODEL = 1024
BATCH = 2
SEQ = 8192
DEPTH = 1
DEC_BATCH = 128
DEC_SEQ = 8
PAST_LEN = 2048
PAGE_SIZE = 128

N_META = 16
MIX_WIDTH = D_MODEL
ATTN_WIDTH = MIX_WIDTH // 2
LRU_WIDTH = MIX_WIDTH - ATTN_WIDTH
HEAD_DIM = 64
N_HEADS = ATTN_WIDTH // HEAD_DIM
LRU_BLOCKS = 8
LRU_BLOCK_W = LRU_WIDTH // LRU_BLOCKS
LRU_C = 8.0
CONV_WIDTH = 4
D_FF = 4 * D_MODEL
Q_BLOCK = 128
RMS_EPS = 1e-6
SB_BIAS_INIT = -6.0

kernel_name = "hymba_stickbreak_rglru_decode_step"


def rmsnorm(x, g):
    xf = x.astype(jnp.float32)
    y = xf * lax.rsqrt(jnp.mean(xf * xf, axis=-1, keepdims=True) + RMS_EPS) * g.astype(jnp.float32)
    return y.astype(x.dtype)


def sb_attend(q, q_pos, k, v, k_pos, bias):
    z = jnp.einsum('bqhd,bkhd->bhqk', q.astype(jnp.float32), k.astype(jnp.float32)) * (HEAD_DIM ** -0.5)
    z = z + bias.astype(jnp.float32)[None, :, None, None]
    mask = k_pos[None, :] < q_pos[:, None]
    log_keep = jnp.where(mask, jax.nn.log_sigmoid(-z), 0.0)
    suffix = lax.cumsum(log_keep, axis=3, reverse=True) - log_keep
    w = jnp.where(mask, jnp.exp(jax.nn.log_sigmoid(z) + suffix), 0.0)
    return jnp.einsum('bhqk,bkhd->bqhd', w, v.astype(jnp.float32)).astype(v.dtype)


def sb_prompt(q, k, v, bias):
    B, T = q.shape[0], q.shape[1]
    pos = jnp.arange(T)
    out_meta = sb_attend(q[:, :N_META], pos[:N_META], k, v, pos, bias)
    n_blk = (T - N_META) // Q_BLOCK
    qr = q[:, N_META:].reshape(B, n_blk, Q_BLOCK, N_HEADS, HEAD_DIM).swapaxes(0, 1)
    pr = pos[N_META:].reshape(n_blk, Q_BLOCK)
    out = lax.map(lambda a: sb_attend(a[0], a[1], k, v, pos, bias), (qr, pr))
    out = out.swapaxes(0, 1).reshape(B, T - N_META, N_HEADS, HEAD_DIM)
    return jnp.concatenate([out_meta, out], axis=1)


def sb_sample(q, k, v, bias, cache_k, cache_v, page_table):
    Bd, Tn = q.shape[0], q.shape[1]
    past = page_table.shape[1] * cache_k.shape[1]
    k_past = cache_k[page_table].reshape(Bd, past, N_HEADS, HEAD_DIM).astype(k.dtype)
    v_past = cache_v[page_table].reshape(Bd, past, N_HEADS, HEAD_DIM).astype(v.dtype)
    k_all = jnp.concatenate([k_past, k], axis=1)
    v_all = jnp.concatenate([v_past, v], axis=1)
    pos = jnp.arange(past + Tn)
    return sb_attend(q, pos[past:], k_all, v_all, pos, bias)


def rglru_branch(xl, conv_prev, h_prev, conv_w, conv_b, w_gate_a, b_gate_a, w_gate_x, b_gate_x, lru_lambda):
    B, T, W = xl.shape
    xpad = jnp.concatenate([conv_prev.astype(xl.dtype), xl], axis=1)
    xc = conv_b
    for j in range(CONV_WIDTH):
        xc = xc + xpad[:, j:j + T] * conv_w[j]
    conv_last = xpad[:, -(CONV_WIDTH - 1):]
    xb = xc.reshape(B, T, LRU_BLOCKS, LRU_BLOCK_W)
    r = jax.nn.sigmoid(jnp.einsum('btnc,ncd->btnd', xb, w_gate_a).reshape(B, T, W) + b_gate_a)
    i = jax.nn.sigmoid(jnp.einsum('btnc,ncd->btnd', xb, w_gate_x).reshape(B, T, W) + b_gate_x)
    log_a = -LRU_C * jax.nn.softplus(-lru_lambda.astype(jnp.float32)) * r.astype(jnp.float32)
    a = jnp.exp(log_a)
    b = jnp.sqrt(-jnp.expm1(2.0 * log_a)) * (i * xc).astype(jnp.float32)

    def step(h, ab):
        h = ab[0] * h + ab[1]
        return h, h

    h_last, hs = lax.scan(step, h_prev.astype(jnp.float32), (a.swapaxes(0, 1), b.swapaxes(0, 1)))
    return hs.swapaxes(0, 1).astype(xl.dtype), h_last, conv_last


def layer(x, attend, conv_prev, h_prev, g_mix_pre, g_mix_post, g_mlp_pre, g_mlp_post, w_in,
          conv_w, conv_b, w_gate_a, b_gate_a, w_gate_x, b_gate_x, lru_lambda, w_out, w_up, w_down):
    B, T, _ = x.shape
    hn = rmsnorm(x, g_mix_pre)
    proj = hn @ w_in
    q, k, v, xl, gate = jnp.split(
        proj, [ATTN_WIDTH, 2 * ATTN_WIDTH, 3 * ATTN_WIDTH, 3 * ATTN_WIDTH + LRU_WIDTH], axis=-1)
    q = q.reshape(B, T, N_HEADS, HEAD_DIM)
    k = k.reshape(B, T, N_HEADS, HEAD_DIM)
    v = v.reshape(B, T, N_HEADS, HEAD_DIM)
    attn = attend(q, k, v)
    lru, h_last, conv_last = rglru_branch(xl, conv_prev, h_prev, conv_w, conv_b,
                                          w_gate_a, b_gate_a, w_gate_x, b_gate_x, lru_lambda)
    mixed = jnp.concatenate([attn.reshape(B, T, ATTN_WIDTH), lru * jax.nn.gelu(gate)], axis=-1) @ w_out
    x = x + rmsnorm(mixed, g_mix_post)
    u = jax.nn.relu(rmsnorm(x, g_mlp_pre) @ w_up)
    x = x + rmsnorm((u * u) @ w_down, g_mlp_post)
    return x, k, v, h_last, conv_last


def setup_inputs(seed: int = 0) -> dict:
    key = jax.random.key(seed)
    ks = jax.random.split(key, 24)
    n_pages = PAST_LEN // PAGE_SIZE
    n_pool = (DEC_BATCH * n_pages * 5) // 4
    f32 = jnp.float32
    nrm = lambda k, s, sc: jax.random.normal(k, s, f32) * sc
    page_table = jax.random.permutation(ks[0], n_pool)[:DEC_BATCH * n_pages].reshape(DEC_BATCH, n_pages).astype(jnp.int32)
    u = jax.random.uniform(ks[1], (DEPTH, LRU_WIDTH), f32, 0.9, 0.999)
    s = u ** (1.0 / LRU_C)
    lru_lambda = jnp.log(s) - jnp.log1p(-s)
    return {
        'x_prompt': nrm(ks[2], (BATCH, SEQ, D_MODEL), 1.0),
        'x_sample': nrm(ks[3], (DEC_BATCH, DEC_SEQ, D_MODEL), 1.0),
        'cache_k': nrm(ks[4], (DEPTH, n_pool, PAGE_SIZE, N_HEADS, HEAD_DIM), 1.0),
        'cache_v': nrm(ks[5], (DEPTH, n_pool, PAGE_SIZE, N_HEADS, HEAD_DIM), 1.0),
        'state_h': nrm(ks[6], (DEPTH, DEC_BATCH, LRU_WIDTH), 0.5),
        'state_conv': nrm(ks[7], (DEPTH, DEC_BATCH, CONV_WIDTH - 1, LRU_WIDTH), 1.0),
        'page_table': page_table,
        'meta_tokens': nrm(ks[8], (N_META, D_MODEL), 1.0),
        'g_mix_pre': 1.0 + nrm(ks[9], (DEPTH, D_MODEL), 0.05),
        'g_mix_post': 1.0 + nrm(ks[10], (DEPTH, D_MODEL), 0.05),
        'g_mlp_pre': 1.0 + nrm(ks[11], (DEPTH, D_MODEL), 0.05),
        'g_mlp_post': 1.0 + nrm(ks[12], (DEPTH, D_MODEL), 0.05),
        'w_in': nrm(ks[13], (DEPTH, D_MODEL, 3 * ATTN_WIDTH + 2 * LRU_WIDTH), D_MODEL ** -0.5),
        'sb_bias': SB_BIAS_INIT + nrm(ks[23], (DEPTH, N_HEADS), 0.1),
        'conv_w': nrm(ks[14], (DEPTH, CONV_WIDTH, LRU_WIDTH), CONV_WIDTH ** -0.5),
        'conv_b': nrm(ks[15], (DEPTH, LRU_WIDTH), 0.01),
        'w_gate_a': nrm(ks[16], (DEPTH, LRU_BLOCKS, LRU_BLOCK_W, LRU_BLOCK_W), LRU_BLOCK_W ** -0.5),
        'b_gate_a': nrm(ks[17], (DEPTH, LRU_WIDTH), 0.1),
        'w_gate_x': nrm(ks[18], (DEPTH, LRU_BLOCKS, LRU_BLOCK_W, LRU_BLOCK_W), LRU_BLOCK_W ** -0.5),
        'b_gate_x': nrm(ks[19], (DEPTH, LRU_WIDTH), 0.1),
        'lru_lambda': lru_lambda,
        'w_out': nrm(ks[20], (DEPTH, MIX_WIDTH, D_MODEL), MIX_WIDTH ** -0.5),
        'w_up': nrm(ks[21], (DEPTH, D_MODEL, D_FF), D_MODEL ** -0.5),
        'w_down': nrm(ks[22], (DEPTH, D_FF, D_MODEL), D_FF ** -0.5),
    }


def reference(x_prompt, x_sample, cache_k, cache_v, state_h, state_conv, page_table, meta_tokens,
              g_mix_pre, g_mix_post, g_mlp_pre, g_mlp_post, w_in, sb_bias, conv_w, conv_b, w_gate_a, b_gate_a,
              w_gate_x, b_gate_x, lru_lambda, w_out, w_up, w_down):
    B = x_prompt.shape[0]
    meta = jnp.broadcast_to(meta_tokens.astype(x_prompt.dtype)[None], (B, N_META, D_MODEL))
    xp = jnp.concatenate([meta, x_prompt], axis=1)
    xs = x_sample
    kp_l, vp_l, hp_l, cp_l, ks_l, vs_l, hs_l, cs_l = [], [], [], [], [], [], [], []
    for l in range(DEPTH):
        lw = (g_mix_pre[l], g_mix_post[l], g_mlp_pre[l], g_mlp_post[l], w_in[l], conv_w[l], conv_b[l],
              w_gate_a[l], b_gate_a[l], w_gate_x[l], b_gate_x[l], lru_lambda[l], w_out[l], w_up[l], w_down[l])
        conv0 = jnp.zeros((B, CONV_WIDTH - 1, LRU_WIDTH), xp.dtype)
        h0 = jnp.zeros((B, LRU_WIDTH), jnp.float32)
        attend_p = functools.partial(sb_prompt, bias=sb_bias[l])
        xp, kp, vp, hp, cp = layer(xp, attend_p, conv0, h0, *lw)
        attend_s = functools.partial(sb_sample, bias=sb_bias[l], cache_k=cache_k[l], cache_v=cache_v[l],
                                     page_table=page_table)
        xs, kn, vn, hn, cn = layer(xs, attend_s, state_conv[l], state_h[l], *lw)
        kp_l.append(kp); vp_l.append(vp); hp_l.append(hp); cp_l.append(cp)
        ks_l.append(kn); vs_l.append(vn); hs_l.append(hn); cs_l.append(cn)
    y_prompt = xp[:, N_META:]
    y_sample = xs
    k_prompt = jnp.stack(kp_l, 0)
    v_prompt = jnp.stack(vp_l, 0)
    h_prompt = jnp.stack(hp_l, 0)
    conv_prompt = jnp.stack(cp_l, 0)
    k_sample = jnp.stack(ks_l, 0)
    v_sample = jnp.stack(vs_l, 0)
    h_sample = jnp.stack(hs_l, 0)
    conv_sample = jnp.stack(cs_l, 0)
    return (y_prompt, y_sample, k_prompt, v_prompt, h_prompt, conv_prompt, k_sample, v_sample, h_sample, conv_sample)
```

```cpp
#include <hip/hip_runtime.h>
#include <cstdio>
#include <cstdint>
namespace pg8 {
#define PG8_LAS __attribute__((address_space(3)))
typedef unsigned short bf16_t;
typedef short bf16x8 __attribute__((ext_vector_type(8)));
typedef float f32x4 __attribute__((ext_vector_type(4)));
typedef unsigned u32x4 __attribute__((ext_vector_type(4)));
constexpr int BM = 256, BK = 64, HALF = 128, HTB = HALF * BK * 2  , STAGE_BYTES = 8 * HTB, NXCD = 8, WGM = 8;

__host__ __device__ __forceinline__ int lds_byte(int r, int c) { const int st = (r >> 4) * 2 + (c >> 5), rr = r & 15, cc = c & 31, ob = rr * 64 + cc * 2; return st * 1024 + (ob ^ (((ob >> 9) & 1) << 5)); }
__host__ __device__ __forceinline__ void stage_rc(int b, int& R, int& C) { const int st = b / 1024, sb = b % 1024, swz = sb ^ (((sb >> 9) & 1) << 5); R = (st >> 1) * 16 + swz / 64; C = (st & 1) * 32 + (swz % 64) / 2; }
__host__ __device__ __forceinline__ int perm32(int rho) { const int n = rho >> 4, i = rho & 15; return 8 * (i >> 2) + 4 * n + (i & 3); }

struct Unit { int pm, pn, kb, nk, part; };
struct Gemm { const bf16_t* A; const bf16_t* Bt; int M, N, K; };

struct StaticOrder {
    int nM, nN, nwg, G, c, nkp, lim;
    __host__ __device__ void init(int M, int N, int K, int G_, int c_) { nM = M / BM; nN = N / BM; nwg = nM * nN; G = G_; c = c_; nkp = K / (2 * BK); lim = nwg; }
    __host__ __device__ void unit_of(int L, Unit& u) const {
        int wgid = L; { const int q = nwg / NXCD, r = nwg % NXCD, xcd = wgid % NXCD, off = wgid / NXCD; wgid = (xcd < r ? xcd * (q + 1) : r * (q + 1) + (xcd - r) * q) + off; }
        const int nig = WGM * nN, gid = wgid / nig, fm = gid * WGM, gsz = (nM - fm) < WGM ? (nM - fm) : WGM;
        u.pm = fm + ((wgid % nig) % gsz); u.pn = (wgid % nig) / gsz; u.kb = 0; u.nk = nkp; u.part = 0;
    }
    __host__ __device__ bool next(int i, Unit& u) const {
        const long L = (long)i * G + c; if (L >= lim) return false;
        unit_of((int)L, u); return true;
    }
    __device__ __forceinline__ void a_ready(const Unit&) const {}
    __device__ __forceinline__ void done(const Unit&) const {}
};
struct SplitTailOrder {
    StaticOrder so; int rounds, nfull, E, NS;
    __host__ __device__ void init(int M, int N, int K, int G, int c) { so.init(M, N, K, G, c); rounds = so.nwg / G; nfull = rounds * G; so.lim = nfull; E = so.nwg - nfull; NS = 1;
        while (E > 0 && NS * 2 * E <= G && (so.nkp % (NS * 2)) == 0) NS *= 2; }
    __host__ __device__ bool next(int i, Unit& u) const {
        if (i < rounds) return so.next(i, u);
        if (i > rounds || so.c >= E * NS) return false;
        const int e = so.c / NS, sl = so.c % NS; so.unit_of(nfull + e, u); u.nk = so.nkp / NS; u.kb = sl * u.nk; u.part = 1 + e * NS + sl; return true;
    }
    __device__ __forceinline__ void a_ready(const Unit&) const {}
    __device__ __forceinline__ void done(const Unit&) const {}
};

__device__ __forceinline__ unsigned cvt_pk_bf16(float lo, float hi) { unsigned r; asm volatile("v_cvt_pk_bf16_f32 %0, %1, %2" : "=v"(r) : "v"(lo), "v"(hi)); return r; }
typedef float f32x2 __attribute__((ext_vector_type(2)));

struct EpiProj {
    static constexpr bool PERM = true, AFTER_DRAIN = false;
    bf16_t* O; size_t split_stride; float scale0; float* kp; float* vp; float* ks; float* vs; int mp; int mreal;
    __device__ __forceinline__ void operator()(const f32x4 (&acc)[2][2][4][2], const Unit& u, int wr, int wc, int fr, int fq) const {
        const int row0 = u.pm * BM + wr * 64 + fr;
        const int t = (u.pn * BM) >> 9, colt = (u.pn * BM) & 511;
        bf16_t* base = O + (size_t)t * split_stride;
        const float sc = (t == 0) ? scale0 : 1.f;
        const int col0 = colt + wc * 32 + 8 * fq;
        const bool wf = (t == 1) || (t == 2);
        float* fp = (t == 1) ? kp : vp; float* fs = (t == 1) ? ks : vs;
#pragma unroll
        for (int ai = 0; ai < 2; ++ai)
#pragma unroll
            for (int m = 0; m < 4; ++m) {
                const int row = row0 + ai * HALF + m * 16;
                bf16_t* rowp = base + (size_t)row * 512 + col0;
                float* frow = nullptr;
                if (wf) { if (row < mp) frow = fp + (size_t)row * 512 + col0; else if (row < mreal) frow = fs + (size_t)(row - mp) * 512 + col0; }
#pragma unroll
                for (int bj = 0; bj < 2; ++bj) {
                    const f32x4 a0 = acc[ai][bj][m][0], a1 = acc[ai][bj][m][1];
                    u32x4 w; w.x = cvt_pk_bf16(a0[0] * sc, a0[1] * sc); w.y = cvt_pk_bf16(a0[2] * sc, a0[3] * sc); w.z = cvt_pk_bf16(a1[0] * sc, a1[1] * sc); w.w = cvt_pk_bf16(a1[2] * sc, a1[3] * sc);
                    *(u32x4*)(rowp + bj * HALF) = w;
                    if (frow) { *(f32x4*)(frow + bj * HALF) = a0; *(f32x4*)(frow + bj * HALF + 4) = a1; }
                }
            }
    }
};
struct EpiF32 {
    static constexpr bool PERM = true, AFTER_DRAIN = false;
    float* O; int ldc;
    __device__ __forceinline__ void operator()(const f32x4 (&acc)[2][2][4][2], const Unit& u, int wr, int wc, int fr, int fq) const {
        const int row0 = u.pm * BM + wr * 64 + fr, col0 = u.pn * BM + wc * 32 + 8 * fq;
#pragma unroll
        for (int ai = 0; ai < 2; ++ai)
#pragma unroll
            for (int m = 0; m < 4; ++m) { float* rowp = O + (size_t)(row0 + ai * HALF + m * 16) * ldc + col0;
#pragma unroll
                for (int bj = 0; bj < 2; ++bj) { *(f32x4*)(rowp + bj * HALF) = acc[ai][bj][m][0]; *(f32x4*)(rowp + bj * HALF + 4) = acc[ai][bj][m][1]; } }
    }
};
struct EpiBf16P {
    static constexpr bool PERM = true, AFTER_DRAIN = false;
    bf16_t* O; int ldc;
    __device__ __forceinline__ void operator()(const f32x4 (&acc)[2][2][4][2], const Unit& u, int wr, int wc, int fr, int fq) const {
        const int row0 = u.pm * BM + wr * 64 + fr, col0 = u.pn * BM + wc * 32 + 8 * fq;
#pragma unroll
        for (int ai = 0; ai < 2; ++ai)
#pragma unroll
            for (int m = 0; m < 4; ++m) { bf16_t* rowp = O + (size_t)(row0 + ai * HALF + m * 16) * ldc + col0;
#pragma unroll
                for (int bj = 0; bj < 2; ++bj) { const f32x4 v0 = acc[ai][bj][m][0], v1 = acc[ai][bj][m][1];
                    u32x4 w; w.x = cvt_pk_bf16(v0[0], v0[1]); w.y = cvt_pk_bf16(v0[2], v0[3]); w.z = cvt_pk_bf16(v1[0], v1[1]); w.w = cvt_pk_bf16(v1[2], v1[3]);
                    *(u32x4*)(rowp + bj * HALF) = w; } }
    }
};
struct EpiBf16Slab {
    static constexpr bool PERM = true, AFTER_DRAIN = false;
    bf16_t* O; int ldc; float* slab;
    __device__ __forceinline__ void operator()(const f32x4 (&acc)[2][2][4][2], const Unit& u, int wr, int wc, int fr, int fq) const {
        if (u.part == 0) {
            const int row0 = u.pm * BM + wr * 64 + fr, col0 = u.pn * BM + wc * 32 + 8 * fq;
#pragma unroll
            for (int ai = 0; ai < 2; ++ai)
#pragma unroll
                for (int m = 0; m < 4; ++m) { bf16_t* rowp = O + (size_t)(row0 + ai * HALF + m * 16) * ldc + col0;
#pragma unroll
                    for (int bj = 0; bj < 2; ++bj) { const f32x4 v0 = acc[ai][bj][m][0], v1 = acc[ai][bj][m][1];
                        u32x4 w; w.x = cvt_pk_bf16(v0[0], v0[1]); w.y = cvt_pk_bf16(v0[2], v0[3]); w.z = cvt_pk_bf16(v1[0], v1[1]); w.w = cvt_pk_bf16(v1[2], v1[3]);
                        *(u32x4*)(rowp + bj * HALF) = w; } }
        } else {
            bf16_t* base = (bf16_t*)slab + (size_t)(u.part - 1) * (BM * BM) + (size_t)(wr * 64 + fr) * BM + wc * 32 + 8 * fq;
#pragma unroll
            for (int ai = 0; ai < 2; ++ai)
#pragma unroll
                for (int m = 0; m < 4; ++m) { bf16_t* rowp = base + (size_t)(ai * HALF + m * 16) * BM;
#pragma unroll
                    for (int bj = 0; bj < 2; ++bj) { const f32x4 v0 = acc[ai][bj][m][0], v1 = acc[ai][bj][m][1];
                        u32x4 w; w.x = cvt_pk_bf16(v0[0], v0[1]); w.y = cvt_pk_bf16(v0[2], v0[3]); w.z = cvt_pk_bf16(v1[0], v1[1]); w.w = cvt_pk_bf16(v1[2], v1[3]);
                        *(u32x4*)(rowp + bj * HALF) = w; } }
        }
    }
};
struct EpiRelu2 {
    static constexpr bool PERM = true, AFTER_DRAIN = false;
    bf16_t* O; int ldc;
    __device__ __forceinline__ void operator()(const f32x4 (&acc)[2][2][4][2], const Unit& u, int wr, int wc, int fr, int fq) const {
        const int row0 = u.pm * BM + wr * 64 + fr, col0 = u.pn * BM + wc * 32 + 8 * fq;
#pragma unroll
        for (int ai = 0; ai < 2; ++ai)
#pragma unroll
            for (int m = 0; m < 4; ++m) { bf16_t* rowp = O + (size_t)(row0 + ai * HALF + m * 16) * ldc + col0;
#pragma unroll
                for (int bj = 0; bj < 2; ++bj) { f32x4 v0 = acc[ai][bj][m][0], v1 = acc[ai][bj][m][1];
#pragma unroll
                    for (int e = 0; e < 4; ++e) { const float a = v0[e] > 0.f ? v0[e] : 0.f, b = v1[e] > 0.f ? v1[e] : 0.f; v0[e] = a * a; v1[e] = b * b; }
                    u32x4 w; w.x = cvt_pk_bf16(v0[0], v0[1]); w.y = cvt_pk_bf16(v0[2], v0[3]); w.z = cvt_pk_bf16(v1[0], v1[1]); w.w = cvt_pk_bf16(v1[2], v1[3]);
                    *(u32x4*)(rowp + bj * HALF) = w; } }
    }
};

template <class Epi, class Sched, bool ALIGN_EPI = false, bool SP2 = false>
__device__ __forceinline__ void gemm_phase(PG8_LAS unsigned char* lds, const Gemm g, const Sched& S, const Epi& E) {
    int tid_ = threadIdx.x; asm volatile("" : "+v"(tid_));
    const int tid = tid_, wid = __builtin_amdgcn_readfirstlane(tid >> 6), lane = tid & 63, wr = wid >> 2, wc = wid & 3, fr = lane & 15, fq = lane >> 4;
    const int K = g.K;
    unsigned voffA[2], voffB[2];
#pragma unroll
    for (int i = 0; i < 2; ++i) { int R, C; stage_rc(tid * 16 + i * 8192, R, C); const int Rb = Epi::PERM ? ((R & ~31) + perm32(R & 31)) : R;
        voffA[i] = (unsigned)(R * K + C) * 2u; voffB[i] = (unsigned)(Rb * K + C) * 2u; }
    const size_t kstep = (size_t)(BK * 2);
    const size_t hstep = (size_t)HALF * K * 2;
    const size_t tstep = 2 * hstep;
    const unsigned ldsw = (unsigned)wid * 1024u;
    const int aoff = lds_byte(wr * 64 + fr, fq * 8), boff = lds_byte(wc * 32 + fr, fq * 8);
#define PG8_SA(b, h) (((b) * 2 + (h)) * HTB)
#define PG8_SB(b, h) ((4 + (b) * 2 + (h)) * HTB)
#define PG8_STAGE(bufoff, gbase, voff) do { _Pragma("unroll") for (int _i = 0; _i < 2; ++_i) \
        __builtin_amdgcn_global_load_lds((const unsigned*)((const char*)(gbase) + (voff)[_i]), (PG8_LAS unsigned*)(lds + (bufoff) + ldsw + _i * 8192), 16, 0, 0); } while (0)
#define PG8_LDA(dst, b, h) do { _Pragma("unroll") for (int m = 0; m < 4; ++m) _Pragma("unroll") for (int k = 0; k < 2; ++k) dst[m][k] = *(const PG8_LAS bf16x8*)(lds + PG8_SA(b, h) + aoff + m * 2048 + k * 1024); } while (0)
#define PG8_LDB(dst, b, h) do { _Pragma("unroll") for (int n = 0; n < 2; ++n) _Pragma("unroll") for (int k = 0; k < 2; ++k) dst[n][k] = *(const PG8_LAS bf16x8*)(lds + PG8_SB(b, h) + boff + n * 2048 + k * 1024); } while (0)
#define PG8_MMA(ai, bj, At, Bt) do { __builtin_amdgcn_s_setprio(1); _Pragma("unroll") for (int m = 0; m < 4; ++m) _Pragma("unroll") for (int n = 0; n < 2; ++n) _Pragma("unroll") for (int k = 0; k < 2; ++k) \
        acc[ai][bj][m][n] = __builtin_amdgcn_mfma_f32_16x16x32_bf16(Bt[n][k], At[m][k], acc[ai][bj][m][n], 0, 0, 0); __builtin_amdgcn_s_setprio(0); } while (0)
#define PG8_WAIT_V(n) asm volatile("s_waitcnt vmcnt(" #n ")" ::: "memory")
#define PG8_WAIT_L(n) asm volatile("s_waitcnt lgkmcnt(" #n ")" ::: "memory")
#define PG8_BAR __builtin_amdgcn_s_barrier()
#define PG8_SCHED __builtin_amdgcn_sched_barrier(0)
    Unit cur, nxt; int ui = 0;
    if (!S.next(0, cur)) return;
    f32x4 acc[2][2][4][2];
#pragma unroll
    for (int a = 0; a < 2; ++a)
#pragma unroll
        for (int b = 0; b < 2; ++b)
#pragma unroll
            for (int m = 0; m < 4; ++m)
#pragma unroll
                for (int n = 0; n < 2; ++n) acc[a][b][m][n] = (f32x4){0.f, 0.f, 0.f, 0.f};
    bf16x8 At[4][2], B0[2][2], B1[2][2];
    const char* cA = (const char*)g.A + (size_t)cur.pm * tstep + (size_t)cur.kb * 2 * kstep; const char* cB = (const char*)g.Bt + (size_t)cur.pn * tstep + (size_t)cur.kb * 2 * kstep;
    S.a_ready(cur);
    if constexpr (SP2) {
        PG8_STAGE(PG8_SB(0, 0), cB, voffB); PG8_STAGE(PG8_SB(0, 1), cB + hstep, voffB); PG8_STAGE(PG8_SA(0, 0), cA, voffA); PG8_STAGE(PG8_SA(0, 1), cA + hstep, voffA);
        if (wr == 1) PG8_BAR;
        PG8_WAIT_V(2); PG8_BAR;
        PG8_STAGE(PG8_SB(1, 0), cB + kstep, voffB); PG8_STAGE(PG8_SA(1, 0), cA + kstep, voffA); PG8_STAGE(PG8_SB(1, 1), cB + hstep + kstep, voffB);
        PG8_WAIT_V(6); PG8_BAR;
    } else {
        PG8_STAGE(PG8_SB(0, 0), cB, voffB); PG8_STAGE(PG8_SA(0, 0), cA, voffA); PG8_STAGE(PG8_SB(0, 1), cB + hstep, voffB); PG8_STAGE(PG8_SA(0, 1), cA + hstep, voffA);
        if (wr == 1) PG8_BAR;
        PG8_WAIT_V(4); PG8_BAR;
        PG8_STAGE(PG8_SB(1, 0), cB + kstep, voffB); PG8_STAGE(PG8_SA(1, 0), cA + kstep, voffA); PG8_STAGE(PG8_SB(1, 1), cB + hstep + kstep, voffB);
        PG8_WAIT_V(6); PG8_BAR;
    }
    for (;;) {
        const bool has_next = S.next(ui + 1, nxt);
        const char* nA = has_next ? (const char*)g.A + (size_t)nxt.pm * tstep + (size_t)nxt.kb * 2 * kstep : cA; const char* nB = has_next ? (const char*)g.Bt + (size_t)nxt.pn * tstep + (size_t)nxt.kb * 2 * kstep : cB;
        const int nt = 2 * cur.nk;
        for (int t = 0; t < nt; t += 2) {
            const bool last = (t == nt - 2);
            const char* a1 = cA + (size_t)(t + 1) * kstep;
            const char* a2 = last ? nA : cA + (size_t)(t + 2) * kstep; const char* b2 = last ? nB : cB + (size_t)(t + 2) * kstep;
            const char* a3 = a2 + kstep; const char* b3 = b2 + kstep;
            if (last && has_next) S.a_ready(nxt);
            if constexpr (SP2) {
            PG8_LDB(B0, 0, 0); PG8_LDB(B1, 0, 1); PG8_SCHED; PG8_LDA(At, 0, 0); PG8_STAGE(PG8_SA(1, 1), a1 + hstep, voffA);
            PG8_WAIT_V(8); PG8_WAIT_L(0); PG8_BAR; PG8_MMA(0, 0, At, B0); PG8_MMA(0, 1, At, B1); PG8_BAR; PG8_SCHED;
            PG8_LDA(At, 0, 1); PG8_STAGE(PG8_SB(0, 0), b2, voffB); PG8_STAGE(PG8_SB(0, 1), b2 + hstep, voffB); PG8_STAGE(PG8_SA(0, 0), a2, voffA);
            PG8_WAIT_V(8); PG8_WAIT_L(0); PG8_BAR; PG8_MMA(1, 0, At, B0); PG8_MMA(1, 1, At, B1); PG8_BAR; PG8_SCHED;
            PG8_LDB(B0, 1, 0); PG8_LDB(B1, 1, 1); PG8_SCHED; PG8_LDA(At, 1, 0); PG8_STAGE(PG8_SA(0, 1), a2 + hstep, voffA);
            PG8_WAIT_V(8); PG8_WAIT_L(0); PG8_BAR; PG8_MMA(0, 0, At, B0); PG8_MMA(0, 1, At, B1); PG8_BAR; PG8_SCHED;
            PG8_LDA(At, 1, 1); PG8_STAGE(PG8_SB(1, 0), b3, voffB); PG8_STAGE(PG8_SB(1, 1), b3 + hstep, voffB); PG8_STAGE(PG8_SA(1, 0), a3, voffA);
            PG8_WAIT_V(8); PG8_WAIT_L(0); PG8_BAR; PG8_MMA(1, 0, At, B0); PG8_MMA(1, 1, At, B1); PG8_BAR; PG8_SCHED;
            } else {
            PG8_LDB(B0, 0, 0); PG8_SCHED; PG8_LDA(At, 0, 0); PG8_STAGE(PG8_SA(1, 1), a1 + hstep, voffA);
            PG8_WAIT_L(8); PG8_BAR; PG8_WAIT_L(0); PG8_MMA(0, 0, At, B0); PG8_BAR; PG8_SCHED;
            PG8_LDB(B1, 0, 1); PG8_STAGE(PG8_SB(0, 0), b2, voffB);
            PG8_BAR; PG8_WAIT_L(0); PG8_MMA(0, 1, At, B1); PG8_BAR;
            PG8_LDA(At, 0, 1); PG8_STAGE(PG8_SA(0, 0), a2, voffA);
            PG8_BAR; PG8_WAIT_L(0); PG8_MMA(1, 0, At, B0); PG8_BAR; PG8_SCHED;
            PG8_STAGE(PG8_SB(0, 1), b2 + hstep, voffB);
            PG8_WAIT_V(6); PG8_BAR; PG8_MMA(1, 1, At, B1); PG8_BAR;
            PG8_LDB(B0, 1, 0); PG8_SCHED; PG8_LDA(At, 1, 0); PG8_STAGE(PG8_SA(0, 1), a2 + hstep, voffA);
            PG8_WAIT_L(8); PG8_BAR; PG8_WAIT_L(0); PG8_MMA(0, 0, At, B0); PG8_BAR; PG8_SCHED;
            PG8_LDB(B1, 1, 1); PG8_STAGE(PG8_SB(1, 0), b3, voffB);
            PG8_BAR; PG8_WAIT_L(0); PG8_MMA(0, 1, At, B1); PG8_BAR;
            PG8_LDA(At, 1, 1); PG8_STAGE(PG8_SA(1, 0), a3, voffA);
            PG8_BAR; PG8_WAIT_L(0); PG8_MMA(1, 0, At, B0); PG8_BAR; PG8_SCHED;
            PG8_STAGE(PG8_SB(1, 1), b3 + hstep, voffB);
            PG8_WAIT_V(6); PG8_BAR; PG8_MMA(1, 1, At, B1); PG8_BAR;
            }
        }
        if constexpr (ALIGN_EPI) { if (wr == 0) PG8_BAR; }
        if constexpr (!Epi::AFTER_DRAIN) { E(acc, cur, wr, wc, fr, fq); S.done(cur); }
        if (!has_next) break;
#pragma unroll
        for (int a = 0; a < 2; ++a)
#pragma unroll
            for (int b = 0; b < 2; ++b)
#pragma unroll
                for (int m = 0; m < 4; ++m)
#pragma unroll
                    for (int n = 0; n < 2; ++n) acc[a][b][m][n] = (f32x4){0.f, 0.f, 0.f, 0.f};
        cur = nxt; cA = nA; cB = nB; ++ui;
        if constexpr (ALIGN_EPI) { if (wr == 1) PG8_BAR; }
    }
    PG8_WAIT_V(0);
    if constexpr (!ALIGN_EPI) { if (wr == 0) PG8_BAR; }
    PG8_BAR;
    if constexpr (Epi::AFTER_DRAIN) { E.fused(acc, cur, wr, wc, fr, fq, lds, wid, lane); S.done(cur); }
#undef PG8_SA
#undef PG8_SB
#undef PG8_STAGE
#undef PG8_LDA
#undef PG8_LDB
#undef PG8_MMA
#undef PG8_WAIT_V
#undef PG8_WAIT_L
#undef PG8_BAR
#undef PG8_SCHED
}
}

#define GAS __attribute__((address_space(1)))
#define LAS __attribute__((address_space(3)))
typedef unsigned short bf16;
typedef unsigned v4u __attribute__((ext_vector_type(4)));
typedef float f32x4 __attribute__((ext_vector_type(4)));
typedef float f32x16 __attribute__((ext_vector_type(16)));
typedef short bf16x8 __attribute__((ext_vector_type(8)));
typedef GAS unsigned gu32;
#define RLX_AGENT __ATOMIC_RELAXED, __HIP_MEMORY_SCOPE_AGENT
#define LDS_WAIT() asm volatile("s_waitcnt lgkmcnt(0)" ::: "memory")
#define VM_WAIT() asm volatile("s_waitcnt vmcnt(0)" ::: "memory")
typedef float f32x2_c __attribute__((ext_vector_type(2))); typedef __bf16 bf16x2_c __attribute__((ext_vector_type(2)));
__device__ __forceinline__ unsigned pk2(float lo, float hi) { const f32x2_c v = {lo, hi}; return __builtin_bit_cast(unsigned, __builtin_convertvector(v, bf16x2_c)); }
__device__ __forceinline__ unsigned f2bf(float f) { return pk2(f, 0.f) & 0xffffu; }
__device__ __forceinline__ float bf2f(bf16 v) { return __builtin_bit_cast(float, (unsigned)v << 16); }

#define XB_TMO      128
#define XB_XCNT(j)  (256  + 64 * (j))
#define XB_XSUB(j)  (1280 + 64 * (j))
#define XB_XGEN(j)  (2304 + 64 * (j))
#define XB_TOP      3328
#define XB_TOPGEN   3392
#define XCD_BAR_WORDS 3456
#define XB_SPIN_CAP (1u << 18)

__device__ __forceinline__ unsigned xb_ld(unsigned* p)              { return __hip_atomic_load(p, __ATOMIC_RELAXED, __HIP_MEMORY_SCOPE_AGENT); }
__device__ __forceinline__ unsigned xb_add(unsigned* p, unsigned v) { return __hip_atomic_fetch_add(p, v, __ATOMIC_RELAXED, __HIP_MEMORY_SCOPE_AGENT); }
__device__ __forceinline__ unsigned xb_xcc_id() { return (unsigned)__builtin_amdgcn_s_getreg((3 << 11) | 20) & 0xFu; }
#define XB_SPIN(cond, bar) do { unsigned _sp = 0; while (cond) { __builtin_amdgcn_s_sleep(1); \
    if ((++_sp & 255u) == 0u) { if (xb_ld(&(bar)[XB_TMO])) break; if (_sp > XB_SPIN_CAP) { atomicAdd(&(bar)[XB_TMO], 1u); break; } } } } while (0)

struct XcdBarrier {
    unsigned* bar; unsigned x;
    volatile LAS unsigned* st;
};

__device__ __forceinline__ XcdBarrier xcd_barrier_post(unsigned* bar, volatile LAS unsigned* st) {
    XcdBarrier b; b.bar = bar; b.x = xb_xcc_id(); b.st = st;
    if (threadIdx.x == 0) (void)xb_add(&bar[XB_XCNT(b.x)], 1u);
    return b;
}
__device__ __forceinline__ void xcd_barrier_complete(unsigned* bar, unsigned x, unsigned& nloc, unsigned& nx) {
    const unsigned G = gridDim.x * gridDim.y * gridDim.z;
    unsigned sum, cnt, mine, sp = 0u;
    for (;;) {
        sum = 0u; cnt = 0u; mine = 0u;
#pragma unroll
        for (unsigned j = 0; j < 16; ++j) { const unsigned c = xb_ld(&bar[XB_XCNT(j)]); sum += c; cnt += (c > 0u) ? 1u : 0u; mine = (j == x) ? c : mine; }
        if (sum == G) break;
        __builtin_amdgcn_s_sleep(1);
        if ((++sp & 255u) == 0u) { if (xb_ld(&bar[XB_TMO])) break; if (sp > XB_SPIN_CAP) { atomicAdd(&bar[XB_TMO], 1u); break; } }
    }
    nloc = mine > 0u ? mine : 1u; nx = cnt > 0u ? cnt : 1u;
}

__device__ __forceinline__ void xcd_barrier(const XcdBarrier& b) {
    asm volatile("s_waitcnt vmcnt(0)" ::: "memory");
    __syncthreads();
    if (threadIdx.x == 0) {
        unsigned* bar = b.bar;
        __builtin_amdgcn_s_waitcnt(0);
        unsigned nloc = b.st[0], nx = b.st[1];
        if (nloc == 0u) { xcd_barrier_complete(bar, b.x, nloc, nx); b.st[0] = nloc; b.st[1] = nx; }
        const unsigned old = xb_add(&bar[XB_XSUB(b.x)], 1u);
        const unsigned gen = old / nloc;
        if (old + 1u == (gen + 1u) * nloc) {
            __builtin_amdgcn_fence(__ATOMIC_RELEASE, "agent");
            asm volatile("s_waitcnt vmcnt(0)" ::: "memory");
            (void)xb_add(&bar[XB_TOP], 1u);
        }
        XB_SPIN(xb_ld(&bar[XB_TOP]) < (gen + 1u) * nx, bar);
        __builtin_amdgcn_fence(__ATOMIC_ACQUIRE, "agent");
        asm volatile("s_waitcnt vmcnt(0)" ::: "memory");
    }
    __syncthreads();
}

__device__ __forceinline__ void xcd_arrive(const XcdBarrier& b) {
    asm volatile("s_waitcnt vmcnt(0)" ::: "memory");
    __syncthreads();
    if (threadIdx.x == 0) {
        unsigned* bar = b.bar;
        __builtin_amdgcn_s_waitcnt(0);
        unsigned nloc = b.st[0], nx = b.st[1];
        if (nloc == 0u) { xcd_barrier_complete(bar, b.x, nloc, nx); b.st[0] = nloc; b.st[1] = nx; }
        const unsigned old = xb_add(&bar[XB_XSUB(b.x)], 1u);
        const unsigned gen = old / nloc;
        if (old + 1u == (gen + 1u) * nloc) {
            __builtin_amdgcn_fence(__ATOMIC_RELEASE, "agent");
            asm volatile("s_waitcnt vmcnt(0)" ::: "memory");
            (void)xb_add(&bar[XB_TOP], 1u);
        }
        b.st[2] = (gen + 1u) * nx;
    }
    __syncthreads();
}
__device__ __forceinline__ void xcd_wait_wave(const XcdBarrier& b) {
    const unsigned target = b.st[2];
    XB_SPIN((unsigned)__builtin_amdgcn_readfirstlane(xb_ld(&b.bar[XB_TOP])) < target, b.bar);
    __builtin_amdgcn_fence(__ATOMIC_ACQUIRE, "agent");
    asm volatile("s_waitcnt vmcnt(0)" ::: "memory");
}
__device__ __forceinline__ void cnt_arrive(unsigned* cnt) {
    asm volatile("s_waitcnt vmcnt(0)" ::: "memory");
    __syncthreads();
    if (threadIdx.x == 0) { __builtin_amdgcn_fence(__ATOMIC_RELEASE, "agent"); asm volatile("s_waitcnt vmcnt(0)" ::: "memory"); (void)xb_add(cnt, 1u); }
}
__device__ __forceinline__ void cnt_wait_wave(unsigned* cnt, unsigned need, unsigned* bar) {
    XB_SPIN((unsigned)__builtin_amdgcn_readfirstlane(xb_ld(cnt)) < need, bar);
    __builtin_amdgcn_fence(__ATOMIC_ACQUIRE, "agent");
    asm volatile("s_waitcnt vmcnt(0)" ::: "memory");
}

struct OneUnitOrder {
    pg8::Unit u0;
    __device__ __forceinline__ bool next(int i, pg8::Unit& u) const { if (i != 0) return false; u = u0; return true; }
    __device__ __forceinline__ void a_ready(const pg8::Unit&) const {}
    __device__ __forceinline__ void done(const pg8::Unit&) const {}
};
struct DownOrder {
    pg8::StaticOrder so; int slice; const XcdBarrier* b; unsigned* cntB;
    __device__ __forceinline__ bool next(int i, pg8::Unit& u) const {
        if (i == 0) return so.next(0, u);
        if (i != 1 || slice < 0) return false;
        const int e = slice >> 3, sl = slice & 7; u.pm = 64 + (e >> 2); u.pn = e & 3; u.nk = so.nkp / 8; u.kb = sl * u.nk; u.part = 1 + slice; return true;
    }
    __device__ __forceinline__ void a_ready(const pg8::Unit& u) const {
        if (threadIdx.x < 64) { if (u.part == 0) xcd_wait_wave(*b); else cnt_wait_wave(cntB, 80u, b->bar); }
        asm volatile("" ::: "memory"); __builtin_amdgcn_s_barrier(); asm volatile("" ::: "memory");
    }
    __device__ __forceinline__ void done(const pg8::Unit&) const {}
};

constexpr int NWAVES = 8;
constexpr int D = 1024, TP = 8208, NBATCH = 2, SEQ = 8192, NMETA = 16;
constexpr int MP = NBATCH * TP;
constexpr int MSAMP = 1024;
constexpr int MREAL = MP + MSAMP;
constexpr int MPAD = 17664;
constexpr int FF = 4096, NPROJ = 2560, AW = 512, HD = 64;
constexpr int DEC_B = 128, NPAGES = 16;
constexpr int NCHUNK = 129;
constexpr float RMS_EPS = 1e-6f;
constexpr float LOG2E = 1.4426950408889634f;
constexpr float QSCALE = 0.125f * LOG2E;

constexpr size_t O_YP = 0, O_YS = O_YP + (size_t)NBATCH * SEQ * D, O_KP = O_YS + (size_t)MSAMP * D, O_VP = O_KP + (size_t)MP * AW, O_HP = O_VP + (size_t)MP * AW,
                 O_CP = O_HP + NBATCH * AW, O_KS = O_CP + NBATCH * 3 * AW, O_VS = O_KS + (size_t)MSAMP * AW, O_HS = O_VS + (size_t)MSAMP * AW, O_CS = O_HS + DEC_B * AW, O_END = O_CS + DEC_B * 3 * AW;
static_assert(O_END == 35950592, "output size");

constexpr size_t MiB = 1u << 20;
constexpr size_t WS_CTL = 0, CTL_ZERO_BYTES = 1 * MiB;
constexpr size_t WS_WIN = 2 * MiB, WS_WOUT = 8 * MiB, WS_WUP = 10 * MiB, WS_WDN = 18 * MiB;
constexpr size_t WS_XN = 32 * MiB;
constexpr size_t WS_Q = 68 * MiB, WS_SPLIT = 18 * MiB;
constexpr size_t WS_K = WS_Q + WS_SPLIT, WS_V = WS_Q + 2 * WS_SPLIT, WS_XL = WS_Q + 3 * WS_SPLIT, WS_GATE = WS_Q + 4 * WS_SPLIT;
constexpr size_t WS_MIX = 158 * MiB;
constexpr size_t WS_MIXED = 194 * MiB;
constexpr size_t WS_X1 = 266 * MiB;
constexpr size_t WS_XN2 = 338 * MiB;
constexpr size_t WS_H = 374 * MiB;
constexpr size_t WS_DOWN = 514 * MiB;
constexpr size_t WS_HLOC = 586 * MiB, WS_ACUM = 620 * MiB;
constexpr size_t WS_ATOT = 654 * MiB, WS_BTOT = 656 * MiB;
constexpr size_t WS_OPART = 658 * MiB, WS_RPART = 662 * MiB, WS_SLAB = 664 * MiB, WS_RS0 = 728 * MiB, WS_END = 729 * MiB;
static_assert((size_t)MPAD * D * 2 <= 36 * MiB && (size_t)MPAD * 512 * 2 <= WS_SPLIT && (size_t)MPAD * D * 4 <= 72 * MiB && (size_t)MPAD * FF * 2 <= 140 * MiB && (size_t)MP * 512 * 4 <= 34 * MiB, "ws map");
constexpr int CW_BAR = 4096, CW_CNTB = 8192, CW_CNTC = 8256;

constexpr int RING_BYTES = 131072;
constexpr int LDSCTL_OFF = RING_BYTES, MISC_OFF = LDSCTL_OFF + 320;
constexpr int LDS_BYTES = 163840;

__device__ __forceinline__ float wave_sum(float v) {
#pragma unroll
    for (int o = 1; o < 64; o <<= 1) v += __shfl_xor(v, o);
    return v;
}
__device__ __forceinline__ void p0_transpose_item(const float* W, int K, int N, bf16* WT, int row_off, LAS float* scr, int item, int lane) {
    const int nblk = N / 32, kb = item / nblk, nb = item % nblk, k0 = 64 * kb, n0 = 32 * nb;
#pragma unroll 8
    for (int i = 0; i < 32; ++i) { const int kk = 2 * i + (lane >> 5); scr[kk * 33 + (lane & 31)] = W[(size_t)(k0 + kk) * N + n0 + (lane & 31)]; }
    LDS_WAIT(); asm volatile("" ::: "memory");
    const int c = lane & 7;
#pragma unroll
    for (int j = 0; j < 4; ++j) { const int n = (lane >> 3) + 8 * j; const LAS float* s = scr + (8 * c) * 33 + n;
        v4u o; o.x = pk2(s[0 * 33], s[1 * 33]); o.y = pk2(s[2 * 33], s[3 * 33]); o.z = pk2(s[4 * 33], s[5 * 33]); o.w = pk2(s[6 * 33], s[7 * 33]);
        *(GAS v4u*)(WT + (size_t)(row_off + n0 + n) * K + k0 + 8 * c) = o; }
    LDS_WAIT(); asm volatile("" ::: "memory");
}
__device__ __forceinline__ const float* xrow_ptr(int r, const float* xp, const float* xs, const float* meta) {
    if (r < MP) { const int b = r >= TP ? 1 : 0; const int t = r - b * TP; return t < NMETA ? meta + (size_t)t * D : xp + ((size_t)b * SEQ + (t - NMETA)) * D; }
    return xs + (size_t)(r - MP) * D;
}
__device__ __forceinline__ float dot4(f32x4 a) { return (a.x * a.x + a.y * a.y) + (a.z * a.z + a.w * a.w); }
__device__ __forceinline__ f32x4 unpack4(unsigned long long w) { const unsigned lo = (unsigned)w, hi = (unsigned)(w >> 32); return (f32x4){__builtin_bit_cast(float, lo << 16), __builtin_bit_cast(float, lo & 0xffff0000u), __builtin_bit_cast(float, hi << 16), __builtin_bit_cast(float, hi & 0xffff0000u)}; }
__device__ __forceinline__ unsigned long long pack4(f32x4 v) { return (unsigned long long)pk2(v.x, v.y) | ((unsigned long long)pk2(v.z, v.w) << 32); }
__device__ __forceinline__ void rms_row_to_bf16(const float* xrow, const float* g, bf16* orow, float* rs, int lane) {
    const GAS f32x4* xr = (const GAS f32x4*)xrow + lane; const GAS f32x4* gr = (const GAS f32x4*)g + lane;
    f32x4 v[4]; float s = 0.f;
#pragma unroll
    for (int j = 0; j < 4; ++j) { v[j] = xr[64 * j]; s += dot4(v[j]); }
    const float sd = sqrtf(wave_sum(s) * (1.f / D) + RMS_EPS), rstd = 1.0f / sd;
    if (lane == 0) *rs = sd;
    GAS unsigned long long* o8 = (GAS unsigned long long*)orow + lane;
#pragma unroll
    for (int j = 0; j < 4; ++j) { const f32x4 gg = gr[64 * j]; o8[64 * j] = pack4(v[j] * rstd * gg); }
}
__device__ __forceinline__ float sigmoidf_(float x) { return __builtin_amdgcn_rcpf(1.0f + __expf(-x)); }
__device__ __forceinline__ float gelu_tanh(float x) {
    const float t = x * x;
    const float z = x * __builtin_fmaf(t, -2.f * 0.7978845608028654f * 0.044715f * 1.4426950408889634f, -2.f * 0.7978845608028654f * 1.4426950408889634f);
    return x * __builtin_amdgcn_rcpf(1.0f + __builtin_amdgcn_exp2f(z));
}

namespace sb {
typedef short s16x4 __attribute__((ext_vector_type(4)));
typedef unsigned u32x4 __attribute__((ext_vector_type(4)));
typedef LAS const char* lds_cptr;
constexpr int KP = 512;
constexpr int NSLOT = 3, SLOTB = 8192;
constexpr int LDS_K = 0, LDS_V = NSLOT * SLOTB, LDS_OST = 2 * NSLOT * SLOTB, ATT_LDS = LDS_OST + NWAVES * 4096;
__device__ __forceinline__ int crow(int r, int hi) { return (r & 3) + 8 * (r >> 2) + 4 * hi; }
__device__ __forceinline__ void glds16(const void* gsrc, unsigned lds_dst) { unsigned keep;
    asm volatile("s_mov_b32 %0, m0\n\ts_mov_b32 m0, %2\n\ts_nop 0\n\tglobal_load_lds_dwordx4 %1, off\n\ts_mov_b32 m0, %0" : "=&s"(keep) : "v"(gsrc), "s"(lds_dst) : "memory"); }
__device__ __forceinline__ void glds16_nt(const void* gsrc, unsigned lds_dst) { unsigned keep;
    asm volatile("s_mov_b32 %0, m0\n\ts_mov_b32 m0, %2\n\ts_nop 0\n\tglobal_load_lds_dwordx4 %1, off nt\n\ts_mov_b32 m0, %0" : "=&s"(keep) : "v"(gsrc), "s"(lds_dst) : "memory"); }
__device__ __forceinline__ void glds2_k(const void* sb, const void* sb2, unsigned v, unsigned lds_dst) { unsigned keep;
    asm volatile("s_mov_b32 %0, m0\n\ts_mov_b32 m0, %4\n\ts_nop 0\n\tglobal_load_lds_dwordx4 %1, %2\n\ts_add_u32 m0, m0, 0x400\n\ts_nop 0\n\tglobal_load_lds_dwordx4 %1, %3\n\ts_mov_b32 m0, %0"
                 : "=&s"(keep) : "v"(v), "s"(sb), "s"(sb2), "s"(lds_dst) : "memory", "scc"); }
template <int STEP> __device__ __forceinline__ void glds2_g(const void* sb, const void* sb2, unsigned va, unsigned vb, unsigned lds_dst) { unsigned keep;
    asm volatile("s_mov_b32 %0, m0\n\ts_mov_b32 m0, %5\n\ts_nop 0\n\tglobal_load_lds_dwordx4 %1, %3\n\ts_add_u32 m0, m0, %6\n\ts_nop 0\n\tglobal_load_lds_dwordx4 %2, %4\n\ts_mov_b32 m0, %0"
                 : "=&s"(keep) : "v"(va), "v"(vb), "s"(sb), "s"(sb2), "s"(lds_dst), "n"(STEP) : "memory", "scc"); }
__device__ __forceinline__ void glds8_nt(const void* sb, const unsigned (&vo)[8], unsigned lds_dst) { unsigned keep;
    asm volatile("s_mov_b32 %0, m0\n\ts_mov_b32 m0, %10\n\ts_nop 0\n\tglobal_load_lds_dwordx4 %1, %9 nt\n\ts_add_u32 m0, m0, 0x400\n\ts_nop 0\n\tglobal_load_lds_dwordx4 %2, %9 nt\n\ts_add_u32 m0, m0, 0x400\n\ts_nop 0\n\tglobal_load_lds_dwordx4 %3, %9 nt\n\ts_add_u32 m0, m0, 0x400\n\ts_nop 0\n\tglobal_load_lds_dwordx4 %4, %9 nt\n\ts_add_u32 m0, m0, 0x400\n\ts_nop 0\n\tglobal_load_lds_dwordx4 %5, %9 nt\n\ts_add_u32 m0, m0, 0x400\n\ts_nop 0\n\tglobal_load_lds_dwordx4 %6, %9 nt\n\ts_add_u32 m0, m0, 0x400\n\ts_nop 0\n\tglobal_load_lds_dwordx4 %7, %9 nt\n\ts_add_u32 m0, m0, 0x400\n\ts_nop 0\n\tglobal_load_lds_dwordx4 %8, %9 nt\n\ts_mov_b32 m0, %0"
                 : "=&s"(keep) : "v"(vo[0]), "v"(vo[1]), "v"(vo[2]), "v"(vo[3]), "v"(vo[4]), "v"(vo[5]), "v"(vo[6]), "v"(vo[7]), "s"(sb), "s"(lds_dst) : "memory", "scc"); }
__device__ __forceinline__ void glds2_v(const void* sb, const void* sb2, unsigned va, unsigned vb, unsigned lds_dst) { unsigned keep;
    asm volatile("s_mov_b32 %0, m0\n\ts_mov_b32 m0, %5\n\ts_nop 0\n\tglobal_load_lds_dwordx4 %1, %3\n\ts_add_u32 m0, m0, 0x400\n\ts_nop 0\n\tglobal_load_lds_dwordx4 %2, %4\n\ts_mov_b32 m0, %0"
                 : "=&s"(keep) : "v"(va), "v"(vb), "s"(sb), "s"(sb2), "s"(lds_dst) : "memory", "scc"); }
__device__ __forceinline__ float fmul_s(float a, float b) { float r; asm("v_mul_f32_e32 %0, %1, %2" : "=v"(r) : "v"(a), "v"(b)); return r; }
typedef float f32x2_t __attribute__((ext_vector_type(2))); typedef __bf16 bf16x2_t __attribute__((ext_vector_type(2)));
__device__ __forceinline__ unsigned cvtpk_s(float lo, float hi) { f32x2_t v = {lo, hi}; bf16x2_t b = __builtin_convertvector(v, bf16x2_t); return __builtin_bit_cast(unsigned, b); }
#define SB_WAIT_BAR(N) asm volatile("s_waitcnt vmcnt(" #N ") lgkmcnt(0)\n\ts_barrier" ::: "memory")

template <int NHALF, bool MASK>
__device__ __forceinline__ void sb_step(f32x16 (&p)[NHALF], float& rinv, int hi, int klo, int khi, u32x4 (&pw)[2 * NHALF]) {
#pragma unroll
    for (int h = 0; h < NHALF; ++h)
#pragma unroll
        for (int r = 0; r < 16; ++r) { float e = __builtin_amdgcn_exp2f(p[h][r]); if (MASK) { const int k = crow(r, hi) + 32 * h; e = (k >= klo && k < khi) ? e : 0.f; } p[h][r] = e; }
    float tg[4 * NHALF], pe[NHALF][16];
#pragma unroll
    for (int h = 0; h < NHALF; ++h)
#pragma unroll
        for (int g = 0; g < 4; ++g) { const float c0 = 1.f + p[h][4 * g], c1 = 1.f + p[h][4 * g + 1], c2 = 1.f + p[h][4 * g + 2], c3 = 1.f + p[h][4 * g + 3];
            pe[h][4 * g] = 1.f; pe[h][4 * g + 1] = c0; pe[h][4 * g + 2] = fmul_s(c0, c1); pe[h][4 * g + 3] = fmul_s(pe[h][4 * g + 2], c2); tg[4 * h + g] = fmul_s(pe[h][4 * g + 3], c3); }
    float E = 1.f, gp[4 * NHALF];
#pragma unroll
    for (int m = 0; m < 4 * NHALF; ++m) { auto rr = __builtin_amdgcn_permlane32_swap(__float_as_uint(tg[m]), __float_as_uint(tg[m]), false, false);
        const float ev = __uint_as_float(rr[0]), od = __uint_as_float(rr[1]);
        gp[m] = hi ? E * ev : E; E = E * (ev * od); }
    rinv = rinv * __builtin_amdgcn_rcpf(E);
#pragma unroll
    for (int m = 0; m < 4 * NHALF; ++m) gp[m] *= rinv;
#pragma unroll
    for (int h = 0; h < NHALF; ++h) {
#pragma unroll
        for (int g = 0; g < 4; ++g) { const float G = gp[4 * h + g];
            p[h][4 * g] = fmul_s(p[h][4 * g], G); p[h][4 * g + 1] = fmul_s(p[h][4 * g + 1], fmul_s(G, pe[h][4 * g + 1])); p[h][4 * g + 2] = fmul_s(p[h][4 * g + 2], fmul_s(G, pe[h][4 * g + 2])); p[h][4 * g + 3] = fmul_s(p[h][4 * g + 3], fmul_s(G, pe[h][4 * g + 3])); }
        pw[2 * h]     = (u32x4){cvtpk_s(p[h][0], p[h][1]), cvtpk_s(p[h][2], p[h][3]), cvtpk_s(p[h][4], p[h][5]), cvtpk_s(p[h][6], p[h][7])};
        pw[2 * h + 1] = (u32x4){cvtpk_s(p[h][8], p[h][9]), cvtpk_s(p[h][10], p[h][11]), cvtpk_s(p[h][12], p[h][13]), cvtpk_s(p[h][14], p[h][15])};
    }
}

__device__ __forceinline__ void qkt64(f32x16& p0, f32x16& p1, lds_cptr kslot, const bf16x8* qr, const f32x16& cinit, int r32, int hi) {
    lds_cptr kb = kslot + hi * 1024 + r32 * 16;
#pragma unroll
    for (int d0 = 0; d0 < 4; ++d0) {
        const bf16x8 b0 = *(const LAS bf16x8*)(kb + d0 * 2048);
        const bf16x8 b1 = *(const LAS bf16x8*)(kb + d0 * 2048 + 512);
        if (d0 == 0) { p0 = __builtin_amdgcn_mfma_f32_32x32x16_bf16(b0, qr[0], cinit, 0, 0, 0); p1 = __builtin_amdgcn_mfma_f32_32x32x16_bf16(b1, qr[0], cinit, 0, 0, 0); }
        else { p0 = __builtin_amdgcn_mfma_f32_32x32x16_bf16(b0, qr[d0], p0, 0, 0, 0); p1 = __builtin_amdgcn_mfma_f32_32x32x16_bf16(b1, qr[d0], p1, 0, 0, 0); } }
}
__device__ __forceinline__ void pv64(f32x16* o, int vb, bf16x8 pa0, bf16x8 pa1, bf16x8 pa2, bf16x8 pa3) {
#pragma unroll
    for (int d0 = 0; d0 < 2; ++d0) { s16x4 lo[4], hi[4];
#pragma unroll
        for (int ks = 0; ks < 4; ++ks) {
            asm volatile("ds_read_b64_tr_b16 %0,%1 offset:%c2" : "=&v"(lo[ks]) : "v"(vb), "i"(d0 * 4096 + ks * 1024) : "memory");
            asm volatile("ds_read_b64_tr_b16 %0,%1 offset:%c2" : "=&v"(hi[ks]) : "v"(vb), "i"(d0 * 4096 + ks * 1024 + 512) : "memory"); }
        asm volatile("s_waitcnt lgkmcnt(0)" ::: "memory"); __builtin_amdgcn_sched_barrier(0);
#define SB_PK(k) (bf16x8){lo[k][0], lo[k][1], lo[k][2], lo[k][3], hi[k][0], hi[k][1], hi[k][2], hi[k][3]}
        o[d0] = __builtin_amdgcn_mfma_f32_32x32x16_bf16(pa0, SB_PK(0), o[d0], 0, 0, 0);
        o[d0] = __builtin_amdgcn_mfma_f32_32x32x16_bf16(pa1, SB_PK(1), o[d0], 0, 0, 0);
        o[d0] = __builtin_amdgcn_mfma_f32_32x32x16_bf16(pa2, SB_PK(2), o[d0], 0, 0, 0);
        o[d0] = __builtin_amdgcn_mfma_f32_32x32x16_bf16(pa3, SB_PK(3), o[d0], 0, 0, 0);
#undef SB_PK
    }
}

__device__ __forceinline__ void attn_unit(LAS unsigned char* shm, int b, int h, int qbase, const bf16* Q, const bf16* K, const bf16* V, bf16* MIX, float biasl2) {
    const int tid = threadIdx.x, lane = tid & 63, r32 = lane & 31, hi = lane >> 5; const int wid = __builtin_amdgcn_readfirstlane(tid >> 6);
    const long rowbase = (long)b * TP;
    const int qlo = qbase + 32 * wid, qp = qlo + r32;
    const int qpos = (qp - 48) < 0 ? 0 : (qp - 48);
    const bf16* Qrow = Q + (rowbase + qpos) * KP + h * HD;
    const bf16* Kh = K + rowbase * KP + h * HD; const bf16* Vh = V + rowbase * KP + h * HD;
    const unsigned lds0 = (unsigned)(uintptr_t)shm;
    const unsigned kdst = lds0 + LDS_K + wid * 1024, vdst = lds0 + LDS_V + wid * 1024;
#define SB_DMA_KV(t, slot) do { int kr_ = (t) * 64 + lane - 48; kr_ = kr_ < 0 ? 0 : kr_; int vr_ = (t) * 64 + 16 * (wid & 3) + (lane >> 2) - 48; vr_ = vr_ < 0 ? 0 : vr_; \
        glds16(Kh + (long)kr_ * KP + wid * 8, (unsigned)__builtin_amdgcn_readfirstlane(kdst + (slot))); \
        glds16(Vh + (long)vr_ * KP + (wid >> 2) * 32 + (lane & 3) * 8, (unsigned)__builtin_amdgcn_readfirstlane(vdst + (slot))); } while (0)
    const int t0 = (qbase + 255) >> 6;
    SB_DMA_KV(t0, 0); if (t0 >= 1) SB_DMA_KV(t0 - 1, SLOTB);
    bf16x8 qr[4];
#pragma unroll
    for (int d0 = 0; d0 < 4; ++d0) qr[d0] = *(const bf16x8*)(Qrow + d0 * 16 + hi * 8);
    f32x16 o[2]; o[0] = f32x16{}; o[1] = f32x16{}; float rinv = 1.f;
    f32x16 cinit;
#pragma unroll
    for (int r = 0; r < 16; ++r) cinit[r] = biasl2;
    const int vb0 = (int)(lds0 + LDS_V) + ((lane >> 4) & 1) * 32 + (lane & 3) * 8 + (4 * hi + ((lane & 15) >> 2)) * 64;
    const lds_cptr kbase = (lds_cptr)shm + LDS_K;
    int slot = 0;
    for (int t = t0; t >= 0; --t) {
        if (t >= 1) SB_WAIT_BAR(2); else SB_WAIT_BAR(0);
        if (t >= 2) { int s2 = slot + 2 * SLOTB; if (s2 >= NSLOT * SLOTB) s2 -= NSLOT * SLOTB; SB_DMA_KV(t - 2, s2); }
        const int kv0 = 64 * t, kvlo = kv0 < 48 ? 48 : kv0;
        if (kvlo < qlo + 31) {
            f32x16 p[2]; qkt64(p[0], p[1], kbase + slot, qr, cinit, r32, hi);
            u32x4 pw[4];
            if ((kv0 + 63 >= qlo) || t == 0) sb_step<2, true>(p, rinv, hi, t == 0 ? 48 : 0, qp - kv0, pw);
            else sb_step<2, false>(p, rinv, hi, 0, 64, pw);
            pv64(o, vb0 + slot, __builtin_bit_cast(bf16x8, pw[0]), __builtin_bit_cast(bf16x8, pw[1]), __builtin_bit_cast(bf16x8, pw[2]), __builtin_bit_cast(bf16x8, pw[3]));
        }
        slot += SLOTB; if (slot >= NSLOT * SLOTB) slot = 0;
    }
#undef SB_DMA_KV
    { int le = lane; asm volatile("" : "+v"(le));
      const int r32 = le & 31, hi = le >> 5, lane = le;
      LAS bf16* stg = (LAS bf16*)(shm + LDS_OST) + wid * 2048;
#pragma unroll
        for (int r = 0; r < 16; ++r) { const int orow = crow(r, hi);
#pragma unroll
            for (int d0 = 0; d0 < 2; ++d0) stg[orow * 64 + d0 * 32 + r32] = (bf16)f2bf(o[d0][r]); }
        asm volatile("s_waitcnt lgkmcnt(0)" ::: "memory");
#pragma unroll
        for (int i = 0; i < 4; ++i) { const int row = i * 8 + (lane >> 3), ch = lane & 7; const u32x4 v = *(const LAS u32x4*)(stg + row * 64 + ch * 8);
            const int pos = qlo + row - 48;
            if (pos >= 0) *(u32x4*)(MIX + (size_t)(rowbase + pos) * D + h * HD + ch * 8) = v; } }
    asm volatile("s_waitcnt lgkmcnt(0)\n\ts_barrier" ::: "memory");
}

typedef short v4i16_t __attribute__((ext_vector_type(4)));
#define SB_VTR(p) __builtin_bit_cast(s16x4, __builtin_amdgcn_ds_read_tr16_b64_v4i16((LAS v4i16_t*)(p)))
#define SB_PIN() __builtin_amdgcn_sched_barrier(0)
constexpr int KPIECE = 1152, SLOTK = 8 * KPIECE;
struct AttSt { f32x16 o[2]; bf16x8 qr[4]; u32x4 pw[4]; float rinv; };
typedef LAS char* lds_ptr;
template <bool MASK, bool DO_QK, bool DO_PV>
__device__ __forceinline__ void att_step(f32x16& c0, f32x16& c1, f32x16& n0, f32x16& n1, AttSt& st, const float Bf, lds_ptr kcur, const int (&kqo)[4], lds_ptr vprev, int hi, int klo, int khi) {
    bf16x8 kq[3]; s16x4 vl[3], vh[3];
#define SB_KFRAG(i) (*(const LAS bf16x8*)(kcur + kqo[(i) >> 1] + ((i) & 1) * (4 * KPIECE)))
#define SB_VI(k) ((((k) & 1) * 4) + ((k) >> 1))
#define SB_VLO(k) SB_VTR(vprev + (SB_VI(k) >> 2) * 4096 + (SB_VI(k) & 3) * 1024)
#define SB_VHI(k) SB_VTR(vprev + (SB_VI(k) >> 2) * 4096 + (SB_VI(k) & 3) * 1024 + 512)
    if (DO_QK) { kq[0] = SB_KFRAG(0); kq[1] = SB_KFRAG(1); }
    SB_PIN();
    float tg[8], pe2[8], pe3[8];
    const f32x16 zero16 = f32x16{};
#pragma unroll
    for (int gi = 0; gi < 8; ++gi) {
        f32x16& p = (gi < 4) ? c0 : c1; const int g = gi & 3, h = gi >> 2;
        float e[4];
#pragma unroll
        for (int j = 0; j < 4; ++j) { e[j] = __builtin_amdgcn_exp2f(p[4 * g + j]); if (MASK) { const int k = crow(4 * g + j, hi) + 32 * h; e[j] = (k >= klo && k < khi) ? e[j] : 0.f; } p[4 * g + j] = e[j]; }
        const float q0 = __builtin_fmaf(e[0], Bf, 1.f), q1 = __builtin_fmaf(e[1], Bf, 1.f), q2 = __builtin_fmaf(e[2], Bf, 1.f), q3 = __builtin_fmaf(e[3], Bf, 1.f);
        pe2[gi] = fmul_s(q0, q1); pe3[gi] = fmul_s(pe2[gi], q2); tg[gi] = fmul_s(pe3[gi], q3);
        if (DO_QK) { const int d0 = gi >> 1;
            if (gi + 2 < 8) kq[(gi + 2) % 3] = SB_KFRAG(gi + 2);
            if (gi & 1) n1 = __builtin_amdgcn_mfma_f32_32x32x16_bf16(kq[gi % 3], st.qr[d0], d0 == 0 ? zero16 : n1, 0, 0, 0);
            else        n0 = __builtin_amdgcn_mfma_f32_32x32x16_bf16(kq[gi % 3], st.qr[d0], d0 == 0 ? zero16 : n0, 0, 0, 0); }
        if (DO_PV && gi >= 6) { vl[(gi - 6) % 3] = SB_VLO(gi - 6); vh[(gi - 6) % 3] = SB_VHI(gi - 6); }
        SB_PIN();
    }
    float E = 1.f, gp[8];
#pragma unroll
    for (int k = 0; k < 8; ++k) {
        if (DO_PV) { const int ks = k >> 1, d0 = k & 1;
            if (k + 2 < 8) { vl[(k + 2) % 3] = SB_VLO(k + 2); vh[(k + 2) % 3] = SB_VHI(k + 2); }
            const s16x4 a = vl[k % 3], c = vh[k % 3];
            const bf16x8 vf = (bf16x8){a[0], a[1], a[2], a[3], c[0], c[1], c[2], c[3]};
            st.o[d0] = __builtin_amdgcn_mfma_f32_32x32x16_bf16(__builtin_bit_cast(bf16x8, st.pw[ks]), vf, st.o[d0], 0, 0, 0); }
        { auto rr = __builtin_amdgcn_permlane32_swap(__float_as_uint(tg[k]), __float_as_uint(tg[k]), false, false);
          const float ev = __uint_as_float(rr[0]), od = __uint_as_float(rr[1]);
          gp[k] = hi ? E * ev : E; E = E * (ev * od); }
        SB_PIN();
    }
    st.rinv = st.rinv * __builtin_amdgcn_rcpf(E);
    const float rb = st.rinv * Bf;
#pragma unroll
    for (int gi = 0; gi < 8; ++gi) { f32x16& p = (gi < 4) ? c0 : c1; const int g = gi & 3; const float G = fmul_s(gp[gi], rb);
        const float w0 = fmul_s(p[4 * g], G), w1 = fmul_s(p[4 * g + 1], fmul_s(G, __builtin_fmaf(p[4 * g], Bf, 1.f))), w2 = fmul_s(p[4 * g + 2], fmul_s(G, pe2[gi])), w3 = fmul_s(p[4 * g + 3], fmul_s(G, pe3[gi]));
        st.pw[gi >> 1][2 * (gi & 1)] = cvtpk_s(w0, w1); st.pw[gi >> 1][2 * (gi & 1) + 1] = cvtpk_s(w2, w3); }
#undef SB_KFRAG
#undef SB_VI
#undef SB_VLO
#undef SB_VHI
}

__device__ __forceinline__ void attn_unit4(LAS unsigned char* shm, int b, int h, int qbase, const bf16* Q, const bf16* K, const bf16* V, bf16* MIX, float biasl2) {
    const int tid = threadIdx.x, lane = tid & 63, r32 = lane & 31, hi = lane >> 5; const int wid = __builtin_amdgcn_readfirstlane(tid >> 6);
    const long rowbase = (long)b * TP;
    const int qlo = qbase + 32 * wid, qp = qlo + r32;
    const int qpos = (qp - 48) < 0 ? 0 : (qp - 48);
    const bf16* Qrow = Q + (rowbase + qpos) * KP + h * HD;
    const bf16* Kh = K + rowbase * KP + h * HD; const bf16* Vh = V + rowbase * KP + h * HD;
    const unsigned lds0 = (unsigned)(uintptr_t)shm;
    const unsigned kdst = lds0 + LDS_K + wid * 2048, vdst = lds0 + LDS_V + wid * 2048;
    const int vp0 = 2 * wid, vp1 = 2 * wid + 1;
#define SB_DMA_KV(t, slot) do { int kr_ = (t) * 64 + lane - 48; kr_ = kr_ < 0 ? 0 : kr_; \
        int va_ = (t) * 64 + 16 * (vp0 & 3) + (lane >> 2) - 48; va_ = va_ < 0 ? 0 : va_; int vb_ = (t) * 64 + 16 * (vp1 & 3) + (lane >> 2) - 48; vb_ = vb_ < 0 ? 0 : vb_; \
        glds16(Kh + (long)kr_ * KP + wid * 16, (unsigned)__builtin_amdgcn_readfirstlane(kdst + (slot))); \
        glds16(Kh + (long)kr_ * KP + wid * 16 + 8, (unsigned)__builtin_amdgcn_readfirstlane(kdst + 1024 + (slot))); \
        glds16(Vh + (long)va_ * KP + (vp0 >> 2) * 32 + (lane & 3) * 8, (unsigned)__builtin_amdgcn_readfirstlane(vdst + (slot))); \
        glds16(Vh + (long)vb_ * KP + (vp1 >> 2) * 32 + (lane & 3) * 8, (unsigned)__builtin_amdgcn_readfirstlane(vdst + 1024 + (slot))); } while (0)
    const int t0 = (qbase + 127) >> 6;
    SB_DMA_KV(t0, 0); if (t0 >= 1) SB_DMA_KV(t0 - 1, SLOTB);
    bf16x8 qr[4];
#pragma unroll
    for (int d0 = 0; d0 < 4; ++d0) qr[d0] = *(const bf16x8*)(Qrow + d0 * 16 + hi * 8);
    f32x16 o[2]; o[0] = f32x16{}; o[1] = f32x16{}; float rinv = 1.f;
    f32x16 cinit;
#pragma unroll
    for (int r = 0; r < 16; ++r) cinit[r] = biasl2;
    const int vb0 = (int)(lds0 + LDS_V) + ((lane >> 4) & 1) * 32 + (lane & 3) * 8 + (4 * hi + ((lane & 15) >> 2)) * 64;
    const lds_cptr kbase = (lds_cptr)shm + LDS_K;
    int slot = 0;
    for (int t = t0; t >= 0; --t) {
        if (t >= 1) SB_WAIT_BAR(4); else SB_WAIT_BAR(0);
        if (t >= 2) { int s2 = slot + 2 * SLOTB; if (s2 >= NSLOT * SLOTB) s2 -= NSLOT * SLOTB; SB_DMA_KV(t - 2, s2); }
        const int kv0 = 64 * t, kvlo = kv0 < 48 ? 48 : kv0;
        if (kvlo < qlo + 31) {
            f32x16 p[2]; qkt64(p[0], p[1], kbase + slot, qr, cinit, r32, hi);
            u32x4 pw[4];
            if ((kv0 + 63 >= qlo) || t == 0) sb_step<2, true>(p, rinv, hi, t == 0 ? 48 : 0, qp - kv0, pw);
            else sb_step<2, false>(p, rinv, hi, 0, 64, pw);
            pv64(o, vb0 + slot, __builtin_bit_cast(bf16x8, pw[0]), __builtin_bit_cast(bf16x8, pw[1]), __builtin_bit_cast(bf16x8, pw[2]), __builtin_bit_cast(bf16x8, pw[3]));
        }
        slot += SLOTB; if (slot >= NSLOT * SLOTB) slot = 0;
    }
#undef SB_DMA_KV
    { LAS bf16* stg = (LAS bf16*)(shm + LDS_OST) + wid * 2048;
#pragma unroll
        for (int r = 0; r < 16; ++r) { const int orow = crow(r, hi);
#pragma unroll
            for (int d0 = 0; d0 < 2; ++d0) stg[orow * 64 + d0 * 32 + r32] = (bf16)f2bf(o[d0][r]); }
        asm volatile("s_waitcnt lgkmcnt(0)" ::: "memory");
#pragma unroll
        for (int i = 0; i < 4; ++i) { const int row = i * 8 + (lane >> 3), ch = lane & 7; const u32x4 v = *(const LAS u32x4*)(stg + row * 64 + ch * 8);
            const int pos = qlo + row - 48;
            if (pos >= 0) *(u32x4*)(MIX + (size_t)(rowbase + pos) * D + h * HD + ch * 8) = v; } }
    asm volatile("s_waitcnt lgkmcnt(0)\n\ts_barrier" ::: "memory");
}
__device__ __forceinline__ int attn_unit4_barriers(int qbase) { return ((qbase + 127) >> 6) + 2; }

__device__ __forceinline__ void attn_unit_pipe4(LAS unsigned char* shm, int b, int h, int qbase, const bf16* Q, const bf16* K, const bf16* V, bf16* MIX, float biasl2) {
    const int tid = threadIdx.x, lane = tid & 63, r32 = lane & 31, hi = lane >> 5; const int wid = __builtin_amdgcn_readfirstlane(tid >> 6);
    const long rowbase = (long)b * TP;
    const int qlo = qbase + 32 * wid, qp = qlo + r32;
    const int qpos = (qp - 48) < 0 ? 0 : (qp - 48);
    const bf16* Qrow = Q + (rowbase + qpos) * KP + h * HD;
    const bf16* Kh = K + rowbase * KP + h * HD; const bf16* Vh = V + rowbase * KP + h * HD;
    const unsigned lds0 = (unsigned)(uintptr_t)shm;
    constexpr int K4 = 0, V4 = 4 * SLOTK;
    const unsigned kdst = lds0 + K4 + wid * 2 * KPIECE, vdst = lds0 + V4 + wid * 2048;
    const int t0 = (qbase + 127) >> 6;
    const float Bf = __builtin_amdgcn_exp2f(biasl2);
    const int ga = (2 * wid) & 3;
    const int kk = lane >> 3, ksl_ = lane & 7;
    const unsigned koff = (unsigned)(kk * 1024 + ((ksl_ ^ kk) * 16));
    const int kra = 16 * wid + kk - 48, krb = kra + 8;
    const unsigned koffA0 = (unsigned)((kra < 0 ? 0 : kra) * 1024 + ((ksl_ ^ kk) * 16)), koffB0 = (unsigned)((krb < 0 ? 0 : krb) * 1024 + ((ksl_ ^ kk) * 16));
    const unsigned vcol = (unsigned)(((wid >> 1) * 32 + (lane & 3) * 8) * 2);
    const unsigned voff = (unsigned)((16 * ga + (lane >> 2)) * 1024) + vcol;
    const int vra = 16 * ga + (lane >> 2) - 48, vrb = vra + 16;
    const unsigned voffA0 = (unsigned)((vra < 0 ? 0 : vra) * 1024) + vcol, voffB0 = (unsigned)((vrb < 0 ? 0 : vrb) * 1024) + vcol;
    const char* Kb = (const char*)Kh; const char* Vb = (const char*)Vh;
#define SB_DMA_K(j) do { const int t_ = t0 - (j); const unsigned d_ = (unsigned)__builtin_amdgcn_readfirstlane(kdst + ((j) & 3) * SLOTK); \
        if (t_ > 0) { const char* b_ = Kb + (size_t)(t_ * 64 - 48 + 16 * wid) * 1024; glds2_g<KPIECE>(b_, b_ + 8 * 1024, koff, koff, d_); } else glds2_g<KPIECE>(Kb, Kb, koffA0, koffB0, d_); } while (0)
#define SB_DMA_V(j) do { const int t_ = t0 - (j); const unsigned d_ = (unsigned)__builtin_amdgcn_readfirstlane(vdst + ((j) & 3) * SLOTB); \
        if (t_ > 0) { const char* b_ = Vb + (size_t)(t_ * 64 - 48) * 1024; glds2_g<1024>(b_, b_ + 16384, voff, voff, d_); } else glds2_g<1024>(Vb, Vb, voffA0, voffB0, d_); } while (0)
    AttSt st;
#pragma unroll
    for (int d0 = 0; d0 < 4; ++d0) st.qr[d0] = *(const bf16x8*)(Qrow + d0 * 16 + hi * 8);
    st.o[0] = f32x16{}; st.o[1] = f32x16{}; st.rinv = 1.f;
#pragma unroll
    for (int i = 0; i < 4; ++i) st.pw[i] = (u32x4){0u, 0u, 0u, 0u};
    const lds_ptr kp0 = (lds_ptr)shm + K4;
    int kqo[4];
#pragma unroll
    for (int d0 = 0; d0 < 4; ++d0) kqo[d0] = (r32 >> 3) * KPIECE + (r32 & 7) * 128 + (((2 * d0 + hi) ^ (r32 & 7)) * 16);
    const lds_ptr vp0 = (lds_ptr)shm + V4 + ((lane >> 4) & 1) * 32 + (lane & 3) * 8 + (4 * hi + ((lane & 15) >> 2)) * 64;
    SB_WAIT_BAR(0);
    f32x16 sA0, sA1, sB0, sB1;
    { const f32x16 z = f32x16{};
#pragma unroll
      for (int d0 = 0; d0 < 4; ++d0) { const bf16x8 b0 = *(const LAS bf16x8*)(kp0 + kqo[d0]), b1 = *(const LAS bf16x8*)(kp0 + kqo[d0] + 4 * KPIECE);
          sA0 = __builtin_amdgcn_mfma_f32_32x32x16_bf16(b0, st.qr[d0], d0 == 0 ? z : sA0, 0, 0, 0); sA1 = __builtin_amdgcn_mfma_f32_32x32x16_bf16(b1, st.qr[d0], d0 == 0 ? z : sA1, 0, 0, 0); } }
#define SB_ISSUE_AFTER(s) do { if ((s) + 3 <= t0) SB_DMA_K((s) + 3); if ((s) + 4 <= t0) SB_DMA_K((s) + 4); if ((s) + 1 <= t0) SB_DMA_V((s) + 1); if ((s) + 2 <= t0) SB_DMA_V((s) + 2); } while (0)
#define SB_STEP_HEAD(s) do { SB_WAIT_BAR(0); } while (0)
    asm volatile("s_waitcnt lgkmcnt(0)\n\ts_barrier" ::: "memory");
    att_step<true, true, false>(sA0, sA1, sB0, sB1, st, Bf, kp0 + 1 * SLOTK, kqo, vp0, hi, 0, qp - 64 * t0);
    att_step<true, true, true>(sB0, sB1, sA0, sA1, st, Bf, kp0 + 2 * SLOTK, kqo, vp0 + 0 * SLOTB, hi, 0, qp - 64 * (t0 - 1));
    int ksl = 3, vsl = 1;
    for (int s = 2; s < t0; s += 2) {
        SB_STEP_HEAD(s);
        att_step<false, true, true>(sA0, sA1, sB0, sB1, st, Bf, kp0 + ksl * SLOTK, kqo, vp0 + vsl * SLOTB, hi, 0, 64);
        ksl = (ksl + 1) & 3; vsl = (vsl + 1) & 3;
        att_step<false, true, true>(sB0, sB1, sA0, sA1, st, Bf, kp0 + ksl * SLOTK, kqo, vp0 + vsl * SLOTB, hi, 0, 64);
        ksl = (ksl + 1) & 3; vsl = (vsl + 1) & 3;
    }
    SB_STEP_HEAD(t0); att_step<true, false, true>(sA0, sA1, sB0, sB1, st, Bf, kp0, kqo, vp0 + vsl * SLOTB, hi, 48, qp);
    { const int vb = (int)(lds0 + V4) + ((lane >> 4) & 1) * 32 + (lane & 3) * 8 + (4 * hi + ((lane & 15) >> 2)) * 64 + (t0 & 3) * SLOTB;
      pv64(st.o, vb, __builtin_bit_cast(bf16x8, st.pw[0]), __builtin_bit_cast(bf16x8, st.pw[1]), __builtin_bit_cast(bf16x8, st.pw[2]), __builtin_bit_cast(bf16x8, st.pw[3])); }
#undef SB_ISSUE_AFTER
#undef SB_DMA_K
#undef SB_DMA_V
#undef SB_STEP_HEAD
    { int le = lane; asm volatile("" : "+v"(le));
      const int r32 = le & 31, hi = le >> 5, lane = le;
      LAS bf16* stg = (LAS bf16*)(shm + K4) + wid * 2048;
#pragma unroll
        for (int r = 0; r < 16; ++r) { const int orow = crow(r, hi);
#pragma unroll
            for (int d0 = 0; d0 < 2; ++d0) stg[orow * 64 + d0 * 32 + r32] = (bf16)f2bf(st.o[d0][r]); }
        asm volatile("s_waitcnt lgkmcnt(0)" ::: "memory");
#pragma unroll
        for (int i = 0; i < 4; ++i) { const int row = i * 8 + (lane >> 3), ch = lane & 7; const u32x4 v = *(const LAS u32x4*)(stg + row * 64 + ch * 8);
            const int pos = qlo + row - 48;
            if (pos >= 0) *(u32x4*)(MIX + (size_t)(rowbase + pos) * D + h * HD + ch * 8) = v; } }
    asm volatile("s_waitcnt lgkmcnt(0)\n\ts_barrier" ::: "memory");
}

__device__ __forceinline__ int attn_unit_pipe4_barriers(int qbase) { return (((qbase + 127) >> 6) >> 1) + 3; }

__device__ __forceinline__ int att_qbase(int ui) { const int k = ui >> 8, v = ui & 15; return ui >= 1024 ? -64 : 64 + 128 * (k == 0 ? v : k == 1 ? 31 - v : k == 2 ? 32 + v : 63 - v); }
struct AttLoader {
    unsigned koff, koffA0, koffB0, voff, voffA0, voffB0, kdst, vdst; int wid, G, ui, t0, i, last; const bf16* K; const bf16* V; const char* Kb; const char* Vb;
    __device__ __forceinline__ void dma_k(int j) const { const int t_ = t0 - j; const unsigned d_ = (unsigned)__builtin_amdgcn_readfirstlane(kdst + (j & 3) * SLOTK);
        if (t_ > 0) { const char* b_ = Kb + (size_t)(t_ * 64 - 48 + 16 * wid) * 1024; glds2_g<KPIECE>(b_, b_ + 8 * 1024, koff, koff, d_); } else glds2_g<KPIECE>(Kb, Kb, koffA0, koffB0, d_); }
    __device__ __forceinline__ void dma_v(int j) const { const int t_ = t0 - j; const unsigned d_ = (unsigned)__builtin_amdgcn_readfirstlane(vdst + (j & 3) * SLOTB);
        if (t_ > 0) { const char* b_ = Vb + (size_t)(t_ * 64 - 48) * 1024; glds2_g<1024>(b_, b_ + 16384, voff, voff, d_); } else glds2_g<1024>(Vb, Vb, voffA0, voffB0, d_); }
    __device__ __forceinline__ void unit() {
        if (ui >= 1024) { i = -1; return; }
        const int bh = (ui & 255) >> 4, b = bh >> 3, h = bh & 7; const long rowbase = (long)b * TP;
        t0 = (att_qbase(ui) + 127) >> 6; last = (t0 >> 1) + 2; i = 0;
        Kb = (const char*)(K + rowbase * KP + h * HD); Vb = (const char*)(V + rowbase * KP + h * HD);
        dma_k(0); dma_k(1); dma_k(2); dma_v(0);
    }
    __device__ __forceinline__ void init(LAS unsigned char* shm, int wid_, int lane, const bf16* K_, const bf16* V_, int vcu, int G_) {
        wid = wid_; G = G_; K = K_; V = V_; ui = vcu;
        const unsigned lds0 = (unsigned)(uintptr_t)shm;
        kdst = lds0 + wid * 2 * KPIECE; vdst = lds0 + 4 * SLOTK + wid * 2048;
        const int ga = (2 * wid) & 3, kk = lane >> 3, ksl_ = lane & 7;
        koff = (unsigned)(kk * 1024 + ((ksl_ ^ kk) * 16));
        const int kra = 16 * wid + kk - 48, krb = kra + 8;
        koffA0 = (unsigned)((kra < 0 ? 0 : kra) * 1024 + ((ksl_ ^ kk) * 16)); koffB0 = (unsigned)((krb < 0 ? 0 : krb) * 1024 + ((ksl_ ^ kk) * 16));
        const unsigned vcol = (unsigned)(((wid >> 1) * 32 + (lane & 3) * 8) * 2);
        voff = (unsigned)((16 * ga + (lane >> 2)) * 1024) + vcol;
        const int vra = 16 * ga + (lane >> 2) - 48, vrb = vra + 16;
        voffA0 = (unsigned)((vra < 0 ? 0 : vra) * 1024) + vcol; voffB0 = (unsigned)((vrb < 0 ? 0 : vrb) * 1024) + vcol;
        unit();
    }
    __device__ __forceinline__ void tick() {
        if (i < 0) return;
        if (i == last) { ui += G; unit(); return; }
        if (i >= 1) { const int s = 2 * (i - 1);
            if (s + 3 <= t0) dma_k(s + 3); if (s + 4 <= t0) dma_k(s + 4); if (s + 1 <= t0) dma_v(s + 1); if (s + 2 <= t0) dma_v(s + 2); }
        ++i;
    }
};

__device__ __forceinline__ void decode_item(LAS unsigned char* wl, int bd, int h, int s, const bf16* Q, const float* ck, const float* cv, const int* ptab,
                                            const float* kn, const float* vn, float biasl2, float* opart, float* rpart, int& nb, const int natt, const int lat, AttLoader& ld) {
    int lane = threadIdx.x & 63; asm volatile("" : "+v"(lane));
    const int r32 = lane & 31, hi = lane >> 5;
    bf16x8 qr[4];
    { const bf16* Qrow = Q + (size_t)(MP + bd * 8 + (r32 & 7)) * KP + h * HD;
#pragma unroll
      for (int d0 = 0; d0 < 4; ++d0) { bf16x8 v = *(const bf16x8*)(Qrow + d0 * 16 + hi * 8); if (r32 >= 8) v = (bf16x8){0, 0, 0, 0, 0, 0, 0, 0}; qr[d0] = v; } }
    f32x16 o[2]; o[0] = f32x16{}; o[1] = f32x16{}; float rinv = 1.f;
    f32x16 cinit;
#pragma unroll
    for (int r = 0; r < 16; ++r) cinit[r] = biasl2;
    const unsigned ldsw = (unsigned)__builtin_amdgcn_readfirstlane((unsigned)(uintptr_t)wl);
    const int ntile = s ? 33 : 32;
    const int lrow = lane >> 4, lch = lane & 15;
#define DEC_BAR(N) do { asm volatile("s_waitcnt vmcnt(" #N ")" ::: "memory"); if (nb < natt) { asm volatile("s_barrier" ::: "memory"); ++nb; ld.tick(); } } while (0)
#define DEC_SRC(j, KB_, VB_) do { if (s == 1 && (j) == 0) { const size_t off_ = (size_t)bd * 8 * 512 + h * HD; KB_ = kn + off_; VB_ = vn + off_; } \
        else { const int jj_ = s ? (j) - 1 : (j); const int pg_ = (s ? 15 : 7) - (jj_ >> 2); const int koff_ = (3 - (jj_ & 3)) * 32; const int page_ = ptab[bd * NPAGES + pg_]; \
               const size_t off_ = ((size_t)page_ * 128 + koff_) * 512 + h * HD; KB_ = ck + off_; VB_ = cv + off_; } } while (0)
    unsigned dvo[8];
#pragma unroll
    for (int i = 0; i < 8; ++i) dvo[i] = (unsigned)(i * 8192 + lrow * 2048 + ((lch ^ lrow ^ (4 * (i & 3))) * 16));
#define DEC_ISSUE(base_, ldsoff_) glds8_nt((base_), dvo, ldsw + (ldsoff_))
    { const float* kb_; const float* vb_; DEC_SRC(0, kb_, vb_);
      asm volatile("s_waitcnt lgkmcnt(0)" ::: "memory");
      DEC_ISSUE(kb_, 0); DEC_ISSUE(vb_, 8192); }
    DEC_BAR(16);
    for (int j = 0; j < ntile; ++j) {
        const bool isnew = (s == 1 && j == 0);
        const float* kn_ = nullptr; const float* vn_ = nullptr;
        if (j + 1 < ntile) DEC_SRC(j + 1, kn_, vn_);
        if (j == 0) DEC_BAR(0); else DEC_BAR(8);
        f32x16 p[1];
#pragma unroll
        for (int d0 = 0; d0 < 4; ++d0) { const int c = 4 * d0 + 2 * hi;
            const f32x4 a0 = *(const LAS f32x4*)(wl + r32 * 256 + ((c ^ (r32 & 15)) * 16)), a1 = *(const LAS f32x4*)(wl + r32 * 256 + (((c + 1) ^ (r32 & 15)) * 16));
            const u32x4 kw = (u32x4){cvtpk_s(a0.x, a0.y), cvtpk_s(a0.z, a0.w), cvtpk_s(a1.x, a1.y), cvtpk_s(a1.z, a1.w)};
            p[0] = __builtin_amdgcn_mfma_f32_32x32x16_bf16(__builtin_bit_cast(bf16x8, kw), qr[d0], d0 == 0 ? cinit : p[0], 0, 0, 0); }
        u32x4 pw[2];
        if (isnew) sb_step<1, true>(p, rinv, hi, 0, r32 < 8 ? r32 : 8, pw); else sb_step<1, false>(p, rinv, hi, 0, 32, pw);
        asm volatile("s_waitcnt lgkmcnt(0)" ::: "memory");
        if (j + 1 < ntile) DEC_ISSUE(kn_, 0);
        if (j + 1 < ntile) DEC_BAR(8); else DEC_BAR(0);
#pragma unroll
        for (int d0 = 0; d0 < 2; ++d0)
#pragma unroll
            for (int ks = 0; ks < 2; ++ks) { float vv[8]; const int dcol = 32 * d0 + r32;
#pragma unroll
                for (int i = 0; i < 8; ++i) { const int key = crow(i, hi) + 16 * ks; vv[i] = *(const LAS float*)(wl + 8192 + key * 256 + (((dcol >> 2) ^ (key & 15)) * 16) + (dcol & 3) * 4); }
                const u32x4 vw = (u32x4){cvtpk_s(vv[0], vv[1]), cvtpk_s(vv[2], vv[3]), cvtpk_s(vv[4], vv[5]), cvtpk_s(vv[6], vv[7])};
                o[d0] = __builtin_amdgcn_mfma_f32_32x32x16_bf16(__builtin_bit_cast(bf16x8, pw[ks]), __builtin_bit_cast(bf16x8, vw), o[d0], 0, 0, 0); }
        asm volatile("s_waitcnt lgkmcnt(0)" ::: "memory");
        if (j + 1 < ntile) DEC_ISSUE(vn_, 8192);
    }
#undef DEC_BAR
#undef DEC_SRC
#undef DEC_ISSUE
    const int item = (bd * 8 + h) * 2 + s;
#pragma unroll
    for (int d0 = 0; d0 < 2; ++d0)
#pragma unroll
        for (int r = 0; r < 4; ++r) opart[((size_t)item * 8 + r + 4 * hi) * 64 + d0 * 32 + r32] = o[d0][r];
    if (lane < 8) rpart[item * 8 + lane] = rinv;
}
#undef SB_WAIT_BAR
}

constexpr int NTILE_B = 257, NT_PROMPT = 2 * NTILE_B, NT_ALL = NT_PROMPT + 32;
constexpr int LRU_WAVE_LDS = 4608 + 8192;
struct LruC {
    const bf16* XL; const bf16* GATE; bf16* MIX; float* ATOT; float* BTOT; unsigned* LB;
    const float *wga, *bga, *wgx, *bgx, *convw, *convb, *lam, *sh, *sconv;
    float *hp_out, *cp_out, *hs_out, *cs_out;
};
typedef float f32x2v __attribute__((ext_vector_type(2)));
__device__ __forceinline__ float one_minus_exp(float x) {
    const float ser = -x * (1.f + x * (0.5f + x * (0.16666667f + x * (0.041666668f + x * 0.0083333338f))));
    const float dir = 1.f - __expf(x);
    return x > -0.25f ? ser : dir;
}
template <int MODE>
__device__ __forceinline__ void lru_phase(LAS unsigned char* wl, int vcu, int G, int n, const LruC& P) {
    int lane_ = threadIdx.x & 63; asm volatile("" : "+v"(lane_));
    const int lane = lane_, r32 = lane & 31, hi = lane >> 5, ch = n * 64 + lane;
    LAS bf16* XA = (LAS bf16*)wl;
    LAS f32x2v* LAG = (LAS f32x2v*)(wl + 4608);
    bf16x8 Ba[2][4], Bx[2][4];
#pragma unroll
    for (int dh = 0; dh < 2; ++dh)
#pragma unroll
        for (int ks = 0; ks < 4; ++ks) {
            const GAS float* wq = (const GAS float*)(P.wga + ((n * 64 + 16 * ks + 8 * hi) * 64 + 32 * dh + r32));
            const GAS float* xq = (const GAS float*)(P.wgx + ((n * 64 + 16 * ks + 8 * hi) * 64 + 32 * dh + r32));
            sb::u32x4 a, x; a.x = pk2(wq[0], wq[64]); a.y = pk2(wq[128], wq[192]); a.z = pk2(wq[256], wq[320]); a.w = pk2(wq[384], wq[448]);
            x.x = pk2(xq[0], xq[64]); x.y = pk2(xq[128], xq[192]); x.z = pk2(xq[256], xq[320]); x.w = pk2(xq[384], xq[448]);
            Ba[dh][ks] = __builtin_bit_cast(bf16x8, a); Bx[dh][ks] = __builtin_bit_cast(bf16x8, x); }
    float bac[2], bxc[2], spc[2];
#pragma unroll
    for (int dh = 0; dh < 2; ++dh) { const int d = n * 64 + 32 * dh + r32; bac[dh] = P.bga[d]; bxc[dh] = P.bgx[d]; spc[dh] = 8.0f * log1pf(__expf(-P.lam[d])); }
    const float cw0 = P.convw[ch], cw1 = P.convw[512 + ch], cw2 = P.convw[1024 + ch], cw3 = P.convw[1536 + ch], cb = P.convb[ch];
    for (int tile = vcu; tile < NT_ALL; tile += G) {
        const bool samp = tile >= NT_PROMPT;
        int row0, nv, b = 0, c = 0;
        if (!samp) { b = tile / NTILE_B; c = tile - b * NTILE_B; nv = c == 0 ? 16 : 32; row0 = b * TP + (c == 0 ? 0 : 16 + 32 * (c - 1)); }
        else { row0 = MP + (tile - NT_PROMPT) * 32; nv = 32; }
        unsigned xr[18];
        const bool first = samp || c == 0;
#pragma unroll
        for (int t = 0; t < 36; t += 2) { const int r0 = t - 3, r1 = t - 2;
            const int q0 = row0 + r0 < 0 ? 0 : row0 + r0, q1 = row0 + r1 < 0 ? 0 : row0 + r1;
            unsigned lo = (unsigned)P.XL[(size_t)q0 * 512 + ch], hi16 = (unsigned)P.XL[(size_t)q1 * 512 + ch];
            lo = (r0 < nv && (!first || r0 >= 0)) ? lo : 0u; hi16 = (t + 1 < 35 && r1 < nv && (!first || r1 >= 0)) ? hi16 : 0u;
            xr[t >> 1] = lo | (hi16 << 16); }
        unsigned gr[16];
        if (MODE >= 1) {
#pragma unroll
            for (int t = 0; t < 32; t += 2) { unsigned lo = (unsigned)P.GATE[(size_t)(row0 + t) * 512 + ch], hi16 = (unsigned)P.GATE[(size_t)(row0 + t + 1) * 512 + ch];
                lo = (t < nv) ? lo : 0u; hi16 = (t + 1 < nv) ? hi16 : 0u; gr[t >> 1] = lo | (hi16 << 16); }
        }
#define LRU_XR(t) __builtin_bit_cast(float, ((t) & 1) ? (xr[(t) >> 1] & 0xffff0000u) : (xr[(t) >> 1] << 16))
#define LRU_GR(t) __builtin_bit_cast(float, ((t) & 1) ? (gr[(t) >> 1] & 0xffff0000u) : (gr[(t) >> 1] << 16))
        float scv[12], shv[4];
        {
#pragma unroll
            for (int q = 0; q < 4; ++q) { const int bd = samp ? ((row0 - MP) >> 3) + q : q;
#pragma unroll
                for (int j = 0; j < 3; ++j) scv[3 * q + j] = P.sconv[(bd * 3 + j) * 512 + ch];
                shv[q] = (MODE >= 1) ? P.sh[bd * 512 + ch] : 0.f; }
        }
        float hst = 0.f, A = 1.f;
        if (MODE == 1 && !samp && c > 0) {
            const int seg = lane >> 4, q = lane & 15, cs = (c + 3) >> 2, lo = seg * cs, hi_ = (lo + cs) < c ? (lo + cs) : c;
            f32x4 A4 = (f32x4){1.f, 1.f, 1.f, 1.f}, B4 = (f32x4){0.f, 0.f, 0.f, 0.f};
            const float* ap = P.ATOT + (size_t)(b * NTILE_B) * 512 + n * 64 + 4 * q; const float* bp = P.BTOT + (size_t)(b * NTILE_B) * 512 + n * 64 + 4 * q;
#pragma unroll 8
            for (int cc = lo; cc < hi_; ++cc) { const f32x4 av = *(const f32x4*)(ap + (size_t)cc * 512), bv = *(const f32x4*)(bp + (size_t)cc * 512); B4 = av * B4 + bv; A4 = av * A4; }
#pragma unroll
            for (int j = 0; j < 4; ++j) LAG[seg * 64 + 4 * q + j] = (f32x2v){A4[j], B4[j]};
            asm volatile("s_waitcnt lgkmcnt(0)" ::: "memory");
#pragma unroll
            for (int sg = 0; sg < 4; ++sg) { const f32x2v ab = LAG[sg * 64 + lane]; hst = ab.x * hst + ab.y; }
            asm volatile("s_waitcnt lgkmcnt(0)" ::: "memory");
        }
        float x0 = LRU_XR(0), x1 = LRU_XR(1), x2 = LRU_XR(2);
#pragma unroll
        for (int t = 0; t < 32; ++t) {
            if ((t & 7) == 0) { x0 = samp ? scv[3 * (t >> 3)] : x0; x1 = samp ? scv[3 * (t >> 3) + 1] : x1; x2 = samp ? scv[3 * (t >> 3) + 2] : x2; }
            const float x3 = LRU_XR(t + 3);
            const float xc = cb + x0 * cw0 + x1 * cw1 + x2 * cw2 + x3 * cw3;
            XA[t * 72 + lane] = (bf16)f2bf(xc);
            x0 = x1; x1 = x2; x2 = x3;
        }
        if (MODE == 0) {
            if (samp) {
#pragma unroll
                for (int q = 0; q < 4; ++q)
#pragma unroll
                    for (int j = 0; j < 3; ++j) P.cs_out[((((row0 - MP) >> 3) + q) * 3 + j) * 512 + ch] = LRU_XR(3 + 8 * q + 5 + j);
            } else if (c == NTILE_B - 1) {
#pragma unroll
                for (int j = 0; j < 3; ++j) P.cp_out[(b * 3 + j) * 512 + ch] = LRU_XR(3 + 29 + j);
            }
        }
        asm volatile("s_waitcnt lgkmcnt(0)" ::: "memory");
        f32x16 ga[2], gx[2];
        {
            bf16x8 Af[4];
#pragma unroll
            for (int ks = 0; ks < 4; ++ks) Af[ks] = *(const LAS bf16x8*)((const LAS char*)XA + r32 * 144 + (16 * ks + 8 * hi) * 2);
#pragma unroll
            for (int dh = 0; dh < 2; ++dh) {
                f32x16 za = f32x16{}, zx = f32x16{};
#pragma unroll
                for (int ks = 0; ks < 4; ++ks) { za = __builtin_amdgcn_mfma_f32_32x32x16_bf16(Af[ks], Ba[dh][ks], za, 0, 0, 0); zx = __builtin_amdgcn_mfma_f32_32x32x16_bf16(Af[ks], Bx[dh][ks], zx, 0, 0, 0); }
                ga[dh] = za; gx[dh] = zx;
            }
        }
        asm volatile("" ::: "memory");
        float hsv[4] = {0.f, 0.f, 0.f, 0.f};
#pragma unroll
        for (int half = 0; half < 2; ++half) {
#pragma unroll
            for (int dh = 0; dh < 2; ++dh)
#pragma unroll
                for (int rr = 0; rr < 8; ++rr) { const int r = 8 * half + rr;
                    const float rg = sigmoidf_(ga[dh][r] + bac[dh]), ig = sigmoidf_(gx[dh][r] + bxc[dh]);
                    const float la = -spc[dh] * rg; const float g2 = __builtin_amdgcn_sqrtf(one_minus_exp(2.f * la)) * ig;
                    LAG[sb::crow(rr, hi) * 64 + 32 * dh + r32] = (f32x2v){la, g2}; }
            asm volatile("s_waitcnt lgkmcnt(0)" ::: "memory");
#pragma unroll
            for (int t16 = 0; t16 < 16; ++t16) { const int t = 16 * half + t16;
                const f32x2v ag = LAG[t16 * 64 + lane];
                if (t < nv) {
                    if (MODE >= 1 && (t & 7) == 0) hst = samp ? shv[t >> 3] : hst;
                    const unsigned lab = pk2(ag.x, ag.y * bf2f(XA[t * 72 + lane]));
                    const float ar = __expf(__builtin_bit_cast(float, lab << 16)), br = __builtin_bit_cast(float, lab & 0xffff0000u);
                    if (MODE == 0) P.LB[(size_t)(row0 + t) * 512 + ch] = lab;
                    hst = ar * hst + br; A *= ar;
                    if (MODE >= 1) {
                        const size_t row = (size_t)(row0 + t);
                        const float g = LRU_GR(t); P.MIX[row * D + 512 + ch] = (bf16)f2bf(hst * gelu_tanh(g));
                        if ((t & 7) == 7) hsv[t >> 3] = hst;
                    }
                }
            }
            asm volatile("s_waitcnt lgkmcnt(0)" ::: "memory");
        }
        if (MODE == 0 && !samp) { P.ATOT[(b * NTILE_B + c) * 512 + ch] = A; P.BTOT[(b * NTILE_B + c) * 512 + ch] = hst; }
        if (MODE >= 1) {
            if (samp) {
#pragma unroll
                for (int q = 0; q < 4; ++q) P.hs_out[(((row0 - MP) >> 3) + q) * 512 + ch] = hsv[q];
            } else if (c == NTILE_B - 1) P.hp_out[b * 512 + ch] = hsv[3];
        }
    }
}
__device__ __forceinline__ void lru_rescan(LAS unsigned char* wl, int vcu, int G, int n, const LruC& P) {
    int lane_ = threadIdx.x & 63; asm volatile("" : "+v"(lane_));
    const int lane = lane_, ch = n * 64 + lane;
    LAS f32x2v* LAG = (LAS f32x2v*)(wl + 4608);
    for (int it = vcu; it < NT_ALL; it += G) {
        const int tile = it < 256 ? it + 1 : it < 512 ? 769 - it : it == 512 ? 0 : it == 513 ? NTILE_B : NT_PROMPT + (it - 514);
        const bool samp = tile >= NT_PROMPT;
        int row0, nv, b = 0, c = 0;
        if (!samp) { b = tile / NTILE_B; c = tile - b * NTILE_B; nv = c == 0 ? 16 : 32; row0 = b * TP + (c == 0 ? 0 : 16 + 32 * (c - 1)); }
        else { row0 = MP + (tile - NT_PROMPT) * 32; nv = 32; }
        unsigned lb[32]; unsigned gr[16]; float shv[4];
#pragma unroll
        for (int t = 0; t < 32; ++t) lb[t] = P.LB[(size_t)(row0 + t) * 512 + ch];
#pragma unroll
        for (int t = 0; t < 32; t += 2) gr[t >> 1] = (unsigned)P.GATE[(size_t)(row0 + t) * 512 + ch] | ((unsigned)P.GATE[(size_t)(row0 + t + 1) * 512 + ch] << 16);
#pragma unroll
        for (int q = 0; q < 4; ++q) shv[q] = P.sh[(samp ? ((row0 - MP) >> 3) + q : q) * 512 + ch];
        float hst = 0.f;
        if (!samp && c > 0) {
            const int seg = lane >> 4, q = lane & 15, cs = (c + 3) >> 2, lo = seg * cs, hi_ = (lo + cs) < c ? (lo + cs) : c;
            f32x4 A4 = (f32x4){1.f, 1.f, 1.f, 1.f}, B4 = (f32x4){0.f, 0.f, 0.f, 0.f};
            const float* ap = P.ATOT + (size_t)(b * NTILE_B) * 512 + n * 64 + 4 * q; const float* bp = P.BTOT + (size_t)(b * NTILE_B) * 512 + n * 64 + 4 * q;
#pragma unroll 16
            for (int cc = lo; cc < hi_; ++cc) { const f32x4 av = *(const f32x4*)(ap + (size_t)cc * 512), bv = *(const f32x4*)(bp + (size_t)cc * 512); B4 = av * B4 + bv; A4 = av * A4; }
#pragma unroll
            for (int j = 0; j < 4; ++j) LAG[seg * 64 + 4 * q + j] = (f32x2v){A4[j], B4[j]};
            asm volatile("s_waitcnt lgkmcnt(0)" ::: "memory");
#pragma unroll
            for (int sg = 0; sg < 4; ++sg) { const f32x2v ab = LAG[sg * 64 + lane]; hst = ab.x * hst + ab.y; }
            asm volatile("s_waitcnt lgkmcnt(0)" ::: "memory");
        }
        float hsv[4] = {0.f, 0.f, 0.f, 0.f};
#pragma unroll
        for (int t = 0; t < 32; ++t) {
            if ((t & 7) == 0) hst = samp ? shv[t >> 3] : hst;
            const float a = __expf(__builtin_bit_cast(float, lb[t] << 16)), bb = __builtin_bit_cast(float, lb[t] & 0xffff0000u);
            const float hn = a * hst + bb; hst = (t < nv) ? hn : hst;
            const float g = __builtin_bit_cast(float, (t & 1) ? (gr[t >> 1] & 0xffff0000u) : (gr[t >> 1] << 16));
            P.MIX[(size_t)((t < nv) ? row0 + t : MREAL + t) * D + 512 + ch] = (bf16)f2bf(hst * gelu_tanh(g));
            if ((t & 7) == 7) hsv[t >> 3] = hst;
        }
        if (samp) {
#pragma unroll
            for (int q = 0; q < 4; ++q) P.hs_out[(((row0 - MP) >> 3) + q) * 512 + ch] = hsv[q];
        } else if (c == NTILE_B - 1) P.hp_out[b * 512 + ch] = hsv[3];
    }
}
__device__ __forceinline__ void dec_combine(int vcu, int G, bf16* MIX, const float* opart, const float* rpart) {
    const int ch = threadIdx.x, hh = ch >> 6, d = ch & 63;
#pragma unroll 4
    for (int srow = vcu; srow < MSAMP; srow += G) { const int bd = srow >> 3, q = srow & 7;
        const int i0 = (bd * 8 + hh) * 2, i1 = i0 + 1;
        const float v = opart[((size_t)i1 * 8 + q) * 64 + d] + rpart[i1 * 8 + q] * opart[((size_t)i0 * 8 + q) * 64 + d];
        MIX[(size_t)(MP + srow) * D + ch] = (bf16)f2bf(v); }
}

#define IDLE_CU_COPY(S_, W_, K_, N_, WT_) do { const int nbusy_ = (S_).nwg % G; if (bx >= nbusy_) { __syncthreads();     \
        LAS float* scr_ = (LAS float*)(L + wave * 16384); int ln_ = threadIdx.x & 63; asm volatile("" : "+v"(ln_)); const int nidle_ = (G - nbusy_) * NWAVES; \
        for (int it_ = (bx - nbusy_) * NWAVES + wave; it_ < ((K_) / 64) * ((N_) / 32); it_ += nidle_) p0_transpose_item((W_), (K_), (N_), (WT_), 0, scr_, it_, ln_); } } while (0)
#define IDLE_CU_COPY_N(NBUSY_, W_, K_, N_, WT_) do { const int nbusy_ = (NBUSY_); if (bx >= nbusy_) { __syncthreads(); \
        LAS float* scr_ = (LAS float*)(L + wave * 16384); int ln_ = threadIdx.x & 63; asm volatile("" : "+v"(ln_)); const int nidle_ = (G - nbusy_) * NWAVES; \
        for (int it_ = (bx - nbusy_) * NWAVES + wave; it_ < ((K_) / 64) * ((N_) / 32); it_ += nidle_) p0_transpose_item((W_), (K_), (N_), (WT_), 0, scr_, it_, ln_); } } while (0)
#ifndef DEC_LAT
#define DEC_LAT 3
#endif
#ifndef PROBE_ATT_REPS
#define PROBE_ATT_REPS 1
#endif
#ifndef PROBE_LRU_REPS
#define PROBE_LRU_REPS 1
#endif
#ifndef PROBE_FIX_REPS
#define PROBE_FIX_REPS 1
#endif
#ifndef PROBE_DEC_REPS
#define PROBE_DEC_REPS 1
#endif
struct Args { const void* in[24]; float* out; unsigned char* ws; };
__global__ void __launch_bounds__(NWAVES * 64, 2) hymba_fwd(Args args) {
    extern __shared__ __attribute__((aligned(16))) unsigned char lds[];
    LAS unsigned char* L = (LAS unsigned char*)lds;
    volatile LAS unsigned* MISC = (volatile LAS unsigned*)(L + MISC_OFF);
    const int tid = threadIdx.x, lane = tid & 63, wave = __builtin_amdgcn_readfirstlane(tid >> 6);
    const int G = gridDim.x; const int bx = blockIdx.x; const int vcu = (G % 8 == 0) ? (bx % 8) * (G / 8) + bx / 8 : bx;
    unsigned char* ws = args.ws;
    gu32* ctl = (gu32*)(ws + WS_CTL);
    const float* x_prompt = (const float*)args.in[0]; const float* x_sample = (const float*)args.in[1];
    const float* cache_k = (const float*)args.in[2]; const float* cache_v = (const float*)args.in[3];
    const float* state_h = (const float*)args.in[4]; const float* state_conv = (const float*)args.in[5];
    const int* page_table = (const int*)args.in[6]; const float* meta = (const float*)args.in[7];
    const float* g_mix_pre = (const float*)args.in[8]; const float* g_mix_post = (const float*)args.in[9];
    const float* g_mlp_pre = (const float*)args.in[10]; const float* g_mlp_post = (const float*)args.in[11];
    const float* w_in = (const float*)args.in[12]; const float* sb_bias = (const float*)args.in[13];
    const float* conv_w = (const float*)args.in[14]; const float* conv_b = (const float*)args.in[15];
    const float* w_gate_a = (const float*)args.in[16]; const float* b_gate_a = (const float*)args.in[17];
    const float* w_gate_x = (const float*)args.in[18]; const float* b_gate_x = (const float*)args.in[19];
    const float* lru_lambda = (const float*)args.in[20]; const float* w_out = (const float*)args.in[21];
    const float* w_up = (const float*)args.in[22]; const float* w_down = (const float*)args.in[23];
    float* out = args.out;
    bf16* WT_IN = (bf16*)(ws + WS_WIN); bf16* WT_OUT = (bf16*)(ws + WS_WOUT); bf16* WT_UP = (bf16*)(ws + WS_WUP); bf16* WT_DN = (bf16*)(ws + WS_WDN);
    bf16* XN = (bf16*)(ws + WS_XN); bf16* QB = (bf16*)(ws + WS_Q); bf16* KB = (bf16*)(ws + WS_K); bf16* VB = (bf16*)(ws + WS_V); bf16* XLB = (bf16*)(ws + WS_XL); bf16* GATEB = (bf16*)(ws + WS_GATE);
    bf16* MIX = (bf16*)(ws + WS_MIX); float* MIXED = (float*)(ws + WS_MIXED); float* X1 = (float*)(ws + WS_X1); bf16* XN2 = (bf16*)(ws + WS_XN2); bf16* HB = (bf16*)(ws + WS_H); float* DOWN = (float*)(ws + WS_DOWN);
    float* RS0 = (float*)(ws + WS_RS0); float* RS2 = RS0 + MPAD;
    float* OPART = (float*)(ws + WS_OPART); float* RPART = (float*)(ws + WS_RPART);

    for (int u = tid; u < (LDS_BYTES - LDSCTL_OFF) / 4; u += NWAVES * 64) ((LAS unsigned*)(L + LDSCTL_OFF))[u] = 0u;
    __syncthreads();
    XcdBarrier bar = xcd_barrier_post((unsigned*)(ctl + CW_BAR), MISC + 8);
    const int gw = vcu * NWAVES + wave, NGW = G * NWAVES;

    {
        LAS float* scr = (LAS float*)(L + wave * 16384);
        constexpr int I_IN = (D / 64) * (NPROJ / 32), I_OUT = (D / 64) * (D / 32), I_UP = (D / 64) * (FF / 32), I_DN = (FF / 64) * (D / 32);
        { int l0 = lane; asm volatile("" : "+v"(l0));
          const GAS f32x4* gq = (const GAS f32x4*)g_mix_pre + l0; f32x4 gg[4];
#pragma unroll
          for (int j = 0; j < 4; ++j) gg[j] = gq[64 * j];
#define P0_LOADB(V_, MB_) do { _Pragma("unroll") for (int r = 0; r < 3; ++r) { const int m_ = (MB_) + r * NGW; const int mc_ = m_ < MREAL ? m_ : MREAL - 1; \
              const GAS f32x4* xr_ = (const GAS f32x4*)xrow_ptr(mc_, x_prompt, x_sample, meta) + l0; _Pragma("unroll") for (int j = 0; j < 4; ++j) V_[r][j] = xr_[64 * j]; } } while (0)
#define P0_DOB(V_, MB_) do { _Pragma("unroll") for (int r = 0; r < 3; ++r) { const int m = (MB_) + r * NGW; \
              if (m < MREAL) { float sq = 0.f; _Pragma("unroll") for (int j = 0; j < 4; ++j) sq += dot4(V_[r][j]); \
                  const float sd = sqrtf(wave_sum(sq) * (1.f / D) + RMS_EPS), rstd = 1.0f / sd; if (l0 == 0) RS0[m] = sd; \
                  GAS unsigned long long* o8 = (GAS unsigned long long*)(XN + (size_t)m * D) + l0; _Pragma("unroll") for (int j = 0; j < 4; ++j) o8[64 * j] = pack4(V_[r][j] * rstd * gg[j]); } \
              else if (m < MPAD) { GAS unsigned long long* a = (GAS unsigned long long*)(XN + (size_t)m * D) + l0; GAS unsigned long long* b2 = (GAS unsigned long long*)(MIX + (size_t)m * D) + l0; GAS unsigned long long* c2 = (GAS unsigned long long*)(XN2 + (size_t)m * D) + l0; \
                  _Pragma("unroll") for (int j = 0; j < 4; ++j) { a[64 * j] = 0ull; b2[64 * j] = 0ull; c2[64 * j] = 0ull; } } } } while (0)
          f32x4 va[3][4], vb[3][4];
          P0_LOADB(va, gw);
          for (int it = gw; it < I_IN; it += NGW) p0_transpose_item(w_in, D, NPROJ, WT_IN, 0, scr, it, lane);
          for (int mb = gw; mb < MPAD; mb += 6 * NGW) {
              if (mb + 3 * NGW < MPAD) P0_LOADB(vb, mb + 3 * NGW);
              P0_DOB(va, mb);
              if (mb + 3 * NGW < MPAD) { if (mb + 6 * NGW < MPAD) P0_LOADB(va, mb + 6 * NGW); P0_DOB(vb, mb + 3 * NGW); }
          }
#undef P0_LOADB
#undef P0_DOB
        }
    }
    xcd_barrier(bar);

    {
        pg8::Gemm g{XN, WT_IN, MPAD, NPROJ, D}; pg8::StaticOrder S; S.init(MPAD, NPROJ, D, G, bx);
        pg8::EpiProj E{QB, (size_t)WS_SPLIT / 2, QSCALE, out + O_KP, out + O_VP, out + O_KS, out + O_VS, MP, MREAL};
        pg8::gemm_phase<pg8::EpiProj, pg8::StaticOrder, true, true>(L, g, S, E);
    }
    xcd_barrier(bar);

    const LruC LP{XLB, GATEB, MIX, (float*)(ws + WS_ATOT), (float*)(ws + WS_BTOT), (unsigned*)(ws + WS_HLOC),
                  w_gate_a, b_gate_a, w_gate_x, b_gate_x, conv_w, conv_b, lru_lambda, state_h, state_conv, out + O_HP, out + O_CP, out + O_HS, out + O_CS};

    {
#define ATT_QBASE(ui) ((ui) >= 1024 ? -64 : 64 + 128 * ((((ui) >> 8) == 0) ? ((ui) & 15) : (((ui) >> 8) == 1) ? 31 - ((ui) & 15) : (((ui) >> 8) == 2) ? 32 + ((ui) & 15) : 63 - ((ui) & 15)))
        int natt = 0;
        const int meta_bh = (vcu >= G - 16) ? G - 1 - vcu : -1;
        for (int ui = vcu; ui < 1024; ui += G) natt += sb::attn_unit_pipe4_barriers(ATT_QBASE(ui));
        if (meta_bh >= 0) natt += sb::attn_unit4_barriers(-64);
        if (wave < 4) {
            for (int ui = vcu; ui < 1024; ui += G) {
                const int bh = (ui & 255) >> 4;
                sb::attn_unit_pipe4(L, bh >> 3, bh & 7, ATT_QBASE(ui), QB, KB, VB, MIX, sb_bias[bh & 7] * LOG2E);
            }
            if (meta_bh >= 0) sb::attn_unit4(L, meta_bh >> 3, meta_bh & 7, -64, QB, KB, VB, MIX, sb_bias[meta_bh & 7] * LOG2E);
        } else {
            int nb = 0; sb::AttLoader ld; ld.init(L, wave - 4, threadIdx.x & 63, KB, VB, vcu, G);
            for (int du = vcu; du < 2 * DEC_B; du += G)
                for (int hh = 0; hh < 2; ++hh) { const int h = (wave - 4) + 4 * hh;
                    sb::decode_item(L + (wave == 7 ? 147456 : 69632 + (wave - 4) * 16384), du >> 1, h, du & 1, QB, cache_k, cache_v, page_table, out + O_KS, out + O_VS, sb_bias[h] * LOG2E, OPART, RPART, nb, natt, DEC_LAT, ld); }
            while (nb < natt) { asm volatile("s_waitcnt vmcnt(0)\n\ts_barrier" ::: "memory"); ++nb; ld.tick(); }
        }
#undef ATT_QBASE
        __syncthreads();
        lru_phase<0>(L + wave * LRU_WAVE_LDS, vcu, G, wave, LP);
        if (vcu >= 34) {
            __syncthreads();
            LAS float* scr = (LAS float*)(L + wave * 16384);
            int lane3 = threadIdx.x & 63; asm volatile("" : "+v"(lane3));
            for (int it = (vcu - 34) * NWAVES + wave; it < (D / 64) * (D / 32); it += (G - 34) * NWAVES) p0_transpose_item(w_out, D, D, WT_OUT, 0, scr, it, lane3);
        }
    }
    xcd_barrier(bar);

    lru_rescan(L + wave * LRU_WAVE_LDS, vcu, G, wave, LP);
    dec_combine(vcu, G, MIX, OPART, RPART);
    xcd_barrier(bar);

    {
        pg8::Gemm g{MIX, WT_OUT, MPAD, D, D}; pg8::StaticOrder S; S.init(64 * 256, D, D, G, bx);
        pg8::EpiBf16P E{(pg8::bf16_t*)MIXED, D};
        pg8::gemm_phase<pg8::EpiBf16P, pg8::StaticOrder, true, true>(L, g, S, E);
        xcd_arrive(bar);
        if (bx < 20) {
            OneUnitOrder S1; S1.u0.pm = 64 + (bx >> 2); S1.u0.pn = bx & 3; S1.u0.kb = 0; S1.u0.nk = D / 128; S1.u0.part = 0;
            pg8::gemm_phase<pg8::EpiBf16P, OneUnitOrder, true, true>(L, g, S1, E);
            cnt_arrive((unsigned*)(ctl + CW_CNTC));
        } else {
            IDLE_CU_COPY_N(20, w_up, D, FF, WT_UP);
            IDLE_CU_COPY_N(20, w_down, FF, D, WT_DN);
        }
    }

    { int lane5 = threadIdx.x & 63; asm volatile("" : "+v"(lane5)); const int lane = lane5;
    f32x4 ig0[4], g1v[4], g2v[4];
#pragma unroll
    for (int j = 0; j < 4; ++j) { const f32x4 gp = ((const GAS f32x4*)g_mix_pre + lane)[64 * j]; ig0[j] = (f32x4){1.f / gp.x, 1.f / gp.y, 1.f / gp.z, 1.f / gp.w}; g1v[j] = ((const GAS f32x4*)g_mix_post + lane)[64 * j]; g2v[j] = ((const GAS f32x4*)g_mlp_pre + lane)[64 * j]; }
    unsigned long long nm[4], nx[4]; float nsd = 0.f;
#define P5_LOAD(mm) do { const GAS unsigned long long* mr_ = (const GAS unsigned long long*)((const bf16*)MIXED + (size_t)(mm) * D) + lane; const GAS unsigned long long* xr_ = (const GAS unsigned long long*)(XN + (size_t)(mm) * D) + lane; \
        _Pragma("unroll") for (int j = 0; j < 4; ++j) { nm[j] = mr_[64 * j]; nx[j] = xr_[64 * j]; } nsd = RS0[(mm)]; } while (0)
    for (int pass = 0; pass < 2; ++pass) {
    if (pass == 0 && bx < 20) continue;
    if (wave == 0) { if (pass == 0) xcd_wait_wave(bar); else { if (bx < 20) xcd_wait_wave(bar); cnt_wait_wave((unsigned*)(ctl + CW_CNTC), 20u, bar.bar); } }
    __syncthreads();
    const int r0 = pass == 0 ? (bx - 20) * NWAVES + wave : 64 * 256 + gw, rstep = pass == 0 ? (G - 20) * NWAVES : NGW, rend = pass == 0 ? 64 * 256 : MREAL;
    if (r0 < rend) P5_LOAD(r0);
    for (int m = r0; m < rend; m += rstep) {
        f32x4 v[4], xv[4]; float s = 0.f; const float sd0 = nsd;
#pragma unroll
        for (int j = 0; j < 4; ++j) { v[j] = unpack4(nm[j]); xv[j] = unpack4(nx[j]); }
        if (m + rstep < rend) P5_LOAD(m + rstep);
#pragma unroll
        for (int j = 0; j < 4; ++j) s += dot4(v[j]);
        const float rstd = 1.0f / sqrtf(wave_sum(s) * (1.f / D) + RMS_EPS);
        float s2 = 0.f;
#pragma unroll
        for (int j = 0; j < 4; ++j) { xv[j] = xv[j] * sd0 * ig0[j] + v[j] * rstd * g1v[j]; s2 += dot4(xv[j]); }
        const float sd2 = sqrtf(wave_sum(s2) * (1.f / D) + RMS_EPS), rstd2 = 1.0f / sd2;
        if (lane == 0) RS2[m] = sd2;
        GAS unsigned long long* o8 = (GAS unsigned long long*)(XN2 + (size_t)m * D) + lane;
#pragma unroll
        for (int j = 0; j < 4; ++j) o8[64 * j] = pack4(xv[j] * rstd2 * g2v[j]);
    }
    }
#undef P5_LOAD
    }
    xcd_barrier(bar);

    unsigned* cntB = (unsigned*)(ctl + CW_CNTB);
    int late_u = -1, early_rank = -1;
    { pg8::StaticOrder sd; sd.init(64 * 256, D, FF, G, bx); pg8::Unit ud; sd.next(0, ud);
      const int x = ud.pm >> 3, pl = ud.pm & 7, nl = x < 4 ? 3 : 2;
      if (pl < nl) late_u = (x < 4 ? 12 * x : 48 + 8 * (x - 4)) + pl * 4 + ud.pn;
      else early_rank = (x < 4 ? 20 * x : 80 + 24 * (x - 4)) + (pl - nl) * 4 + ud.pn; }
    {
        pg8::Gemm g{XN2, WT_UP, MPAD, FF, D}; pg8::StaticOrder S; S.init(64 * 256, FF, D, G, bx);
        pg8::EpiRelu2 E{HB, FF};
        pg8::gemm_phase<pg8::EpiRelu2, pg8::StaticOrder, true, true>(L, g, S, E);
        xcd_arrive(bar);
        if (late_u >= 0) {
            const int u = late_u;
            OneUnitOrder S1; S1.u0.pm = 64 + (u >> 4); S1.u0.pn = u & 15; S1.u0.kb = 0; S1.u0.nk = D / 128; S1.u0.part = 0;
            pg8::gemm_phase<pg8::EpiRelu2, OneUnitOrder, true, true>(L, g, S1, E);
            cnt_arrive(cntB);
        }
    }
    {
        pg8::Gemm g{HB, WT_DN, MPAD, D, FF}; DownOrder S; S.so.init(64 * 256, D, FF, G, bx); S.b = &bar; S.cntB = cntB;
        S.slice = (early_rank >= 0 && early_rank < 160) ? early_rank : -1;
        pg8::EpiBf16Slab E{(pg8::bf16_t*)DOWN, D, (float*)(ws + WS_SLAB)};
        pg8::gemm_phase<pg8::EpiBf16Slab, DownOrder, true, true>(L, g, S, E);
    }
    xcd_barrier(bar);

    { int lane8 = threadIdx.x & 63; asm volatile("" : "+v"(lane8)); const int lane = lane8;
    LAS unsigned char* tab = L;
    for (int t = tid; t < (MPAD / 256) * 4; t += NWAVES * 64) tab[t] = 0;
    __syncthreads();
    if (tid < 20) tab[(64 + (tid >> 2)) * 4 + (tid & 3)] = (unsigned char)(1 + tid);
    __syncthreads();
    const float* slab = (const float*)(ws + WS_SLAB); const int NS8 = 8;
    f32x4 ig2[4];
#pragma unroll
    for (int j = 0; j < 4; ++j) { const f32x4 gp = ((const GAS f32x4*)g_mlp_pre + lane)[64 * j]; ig2[j] = (f32x4){1.f / gp.x, 1.f / gp.y, 1.f / gp.z, 1.f / gp.w}; }
    unsigned long long nd[4], nx[4]; float nsd = 0.f;
#define P8_LOAD(mm) do { const GAS unsigned long long* dr_ = (const GAS unsigned long long*)((const bf16*)DOWN + (size_t)(mm) * D) + lane; const GAS unsigned long long* xr_ = (const GAS unsigned long long*)(XN2 + (size_t)(mm) * D) + lane; \
        _Pragma("unroll") for (int j = 0; j < 4; ++j) { nd[j] = dr_[64 * j]; nx[j] = xr_[64 * j]; } nsd = RS2[(mm)]; } while (0)
    if (gw < MREAL) P8_LOAD(gw);
    const GAS f32x4* g1 = (const GAS f32x4*)g_mlp_post + lane;
    for (int m = gw; m < MREAL; m += NGW) {
        f32x4 v[4], x1v[4]; float s = 0.f; const float sd2 = nsd;
#pragma unroll
        for (int j = 0; j < 4; ++j) { v[j] = unpack4(nd[j]); x1v[j] = unpack4(nx[j]); }
        if (m + NGW < MREAL) P8_LOAD(m + NGW);
        float* dst = nullptr;
        if (m < MP) { const int b = m >= TP ? 1 : 0; const int t = m - b * TP; if (t >= NMETA) dst = out + O_YP + ((size_t)b * SEQ + (t - NMETA)) * D; }
        else dst = out + O_YS + (size_t)(m - MP) * D;
        if (dst == nullptr) continue;
#pragma unroll
        for (int j = 0; j < 4; ++j) {
            const int e1 = tab[(m >> 8) * 4 + j];
            if (e1 != 0) { f32x4 a4 = (f32x4){0.f, 0.f, 0.f, 0.f}; const GAS unsigned long long* sp = (const GAS unsigned long long*)((const bf16*)slab + (size_t)(e1 - 1) * NS8 * 65536 + (size_t)(m & 255) * 256) + lane;
                   for (int sl = 0; sl < NS8; ++sl) a4 = a4 + unpack4(sp[(size_t)sl * 16384]); v[j] = a4; }
            s += dot4(v[j]); }
        const float rstd = 1.0f / sqrtf(wave_sum(s) * (1.f / D) + RMS_EPS);
        GAS f32x4* o4 = (GAS f32x4*)dst + lane;
#pragma unroll
        for (int j = 0; j < 4; ++j) o4[64 * j] = x1v[j] * sd2 * ig2[j] + v[j] * rstd * g1[64 * j];
    }
#undef P8_LOAD
    }
}

extern "C" void kernel_launch(void* const* d_in, const int* in_sizes, int n_in, void* d_out, int out_size, void* d_ws, size_t ws_size, hipStream_t stream) {
    static int grid = 0;
    if (grid == 0) {
        if (n_in != 24 || out_size != (int)O_END || ws_size < WS_END) { fprintf(stderr, "kernel_launch: unexpected shapes: n_in %d out %d ws %zu\n", n_in, out_size, ws_size); grid = -1; return; }
        int dev = 0, cus = 0, per_cu = 0;
        if (hipGetDevice(&dev) != hipSuccess || hipDeviceGetAttribute(&cus, hipDeviceAttributeMultiprocessorCount, dev) != hipSuccess) { grid = -1; return; }
        if (hipFuncSetAttribute((const void*)hymba_fwd, hipFuncAttributeMaxDynamicSharedMemorySize, LDS_BYTES) != hipSuccess) { fprintf(stderr, "kernel_launch: hipFuncSetAttribute failed\n"); grid = -1; return; }
        if (hipOccupancyMaxActiveBlocksPerMultiprocessor(&per_cu, (const void*)hymba_fwd, NWAVES * 64, LDS_BYTES) != hipSuccess || per_cu < 1)
            fprintf(stderr, "kernel_launch: note: occupancy query reports %d workgroups per CU\n", per_cu);
        (void)hipGetLastError();
        grid = cus;
    }
    if (grid < 0) return;
    if (hipMemsetAsync((char*)d_ws + WS_CTL, 0, CTL_ZERO_BYTES, stream) != hipSuccess) return;
    Args a{};
    for (int i = 0; i < 24; ++i) a.in[i] = d_in[i];
    a.out = (float*)d_out; a.ws = (unsigned char*)d_ws;
    hipLaunchKernelGGL(hymba_fwd, dim3(grid), dim3(NWAVES * 64), LDS_BYTES, stream, a);
    const hipError_t le = hipPeekAtLastError();
    if (le != hipSuccess) fprintf(stderr, "kernel_launch: launch failed: %s\n", hipGetErrorName(le));
}
```

```cpp
#include <hip/hip_runtime.h>
#include <cstdio>
#include <cstdint>
namespace pg8 {
#define PG8_LAS __attribute__((address_space(3)))
typedef unsigned short bf16_t;
typedef short bf16x8 __attribute__((ext_vector_type(8)));
typedef float f32x4 __attribute__((ext_vector_type(4)));
typedef unsigned u32x4 __attribute__((ext_vector_type(4)));
constexpr int BM = 256, BK = 64, HALF = 128, HTB = HALF * BK * 2  , STAGE_BYTES = 8 * HTB, NXCD = 8, WGM = 8;

__host__ __device__ __forceinline__ int lds_byte(int r, int c) { const int st = (r >> 4) * 2 + (c >> 5), rr = r & 15, cc = c & 31, ob = rr * 64 + cc * 2; return st * 1024 + (ob ^ (((ob >> 9) & 1) << 5)); }
__host__ __device__ __forceinline__ void stage_rc(int b, int& R, int& C) { const int st = b / 1024, sb = b % 1024, swz = sb ^ (((sb >> 9) & 1) << 5); R = (st >> 1) * 16 + swz / 64; C = (st & 1) * 32 + (swz % 64) / 2; }
__host__ __device__ __forceinline__ int perm32(int rho) { const int n = rho >> 4, i = rho & 15; return 8 * (i >> 2) + 4 * n + (i & 3); }

struct Unit { int pm, pn, kb, nk, part; };
struct Gemm { const bf16_t* A; const bf16_t* Bt; int M, N, K; };

struct StaticOrder {
    int nM, nN, nwg, G, c, nkp, lim;
    __host__ __device__ void init(int M, int N, int K, int G_, int c_) { nM = M / BM; nN = N / BM; nwg = nM * nN; G = G_; c = c_; nkp = K / (2 * BK); lim = nwg; }
    __host__ __device__ void unit_of(int L, Unit& u) const {
        int wgid = L; { const int q = nwg / NXCD, r = nwg % NXCD, xcd = wgid % NXCD, off = wgid / NXCD; wgid = (xcd < r ? xcd * (q + 1) : r * (q + 1) + (xcd - r) * q) + off; }
        const int nig = WGM * nN, gid = wgid / nig, fm = gid * WGM, gsz = (nM - fm) < WGM ? (nM - fm) : WGM;
        u.pm = fm + ((wgid % nig) % gsz); u.pn = (wgid % nig) / gsz; u.kb = 0; u.nk = nkp; u.part = 0;
    }
    __host__ __device__ bool next(int i, Unit& u) const {
        const long L = (long)i * G + c; if (L >= lim) return false;
        unit_of((int)L, u); return true;
    }
    __device__ __forceinline__ void a_ready(const Unit&) const {}
    __device__ __forceinline__ void done(const Unit&) const {}
};
struct SplitTailOrder {
    StaticOrder so; int rounds, nfull, E, NS;
    __host__ __device__ void init(int M, int N, int K, int G, int c) { so.init(M, N, K, G, c); rounds = so.nwg / G; nfull = rounds * G; so.lim = nfull; E = so.nwg - nfull; NS = 1;
        while (E > 0 && NS * 2 * E <= G && (so.nkp % (NS * 2)) == 0) NS *= 2; }
    __host__ __device__ bool next(int i, Unit& u) const {
        if (i < rounds) return so.next(i, u);
        if (i > rounds || so.c >= E * NS) return false;
        const int e = so.c / NS, sl = so.c % NS; so.unit_of(nfull + e, u); u.nk = so.nkp / NS; u.kb = sl * u.nk; u.part = 1 + e * NS + sl; return true;
    }
    __device__ __forceinline__ void a_ready(const Unit&) const {}
    __device__ __forceinline__ void done(const Unit&) const {}
};

__device__ __forceinline__ unsigned cvt_pk_bf16(float lo, float hi) { unsigned r; asm volatile("v_cvt_pk_bf16_f32 %0, %1, %2" : "=v"(r) : "v"(lo), "v"(hi)); return r; }
typedef float f32x2 __attribute__((ext_vector_type(2)));

struct EpiProj {
    static constexpr bool PERM = true, AFTER_DRAIN = false;
    bf16_t* O; size_t split_stride; float scale0; float* kp; float* vp; float* ks; float* vs; int mp; int mreal;
    __device__ __forceinline__ void operator()(const f32x4 (&acc)[2][2][4][2], const Unit& u, int wr, int wc, int fr, int fq) const {
        const int row0 = u.pm * BM + wr * 64 + fr;
        const int t = (u.pn * BM) >> 9, colt = (u.pn * BM) & 511;
        bf16_t* base = O + (size_t)t * split_stride;
        const float sc = (t == 0) ? scale0 : 1.f;
        const int col0 = colt + wc * 32 + 8 * fq;
        const bool wf = (t == 1) || (t == 2);
        float* fp = (t == 1) ? kp : vp; float* fs = (t == 1) ? ks : vs;
#pragma unroll
        for (int ai = 0; ai < 2; ++ai)
#pragma unroll
            for (int m = 0; m < 4; ++m) {
                const int row = row0 + ai * HALF + m * 16;
                bf16_t* rowp = base + (size_t)row * 512 + col0;
                float* frow = nullptr;
                if (wf) { if (row < mp) frow = fp + (size_t)row * 512 + col0; else if (row < mreal) frow = fs + (size_t)(row - mp) * 512 + col0; }
#pragma unroll
                for (int bj = 0; bj < 2; ++bj) {
                    const f32x4 a0 = acc[ai][bj][m][0], a1 = acc[ai][bj][m][1];
                    u32x4 w; w.x = cvt_pk_bf16(a0[0] * sc, a0[1] * sc); w.y = cvt_pk_bf16(a0[2] * sc, a0[3] * sc); w.z = cvt_pk_bf16(a1[0] * sc, a1[1] * sc); w.w = cvt_pk_bf16(a1[2] * sc, a1[3] * sc);
                    *(u32x4*)(rowp + bj * HALF) = w;
                    if (frow) { *(f32x4*)(frow + bj * HALF) = a0; *(f32x4*)(frow + bj * HALF + 4) = a1; }
                }
            }
    }
};
struct EpiF32 {
    static constexpr bool PERM = true, AFTER_DRAIN = false;
    float* O; int ldc;
    __device__ __forceinline__ void operator()(const f32x4 (&acc)[2][2][4][2], const Unit& u, int wr, int wc, int fr, int fq) const {
        const int row0 = u.pm * BM + wr * 64 + fr, col0 = u.pn * BM + wc * 32 + 8 * fq;
#pragma unroll
        for (int ai = 0; ai < 2; ++ai)
#pragma unroll
            for (int m = 0; m < 4; ++m) { float* rowp = O + (size_t)(row0 + ai * HALF + m * 16) * ldc + col0;
#pragma unroll
                for (int bj = 0; bj < 2; ++bj) { *(f32x4*)(rowp + bj * HALF) = acc[ai][bj][m][0]; *(f32x4*)(rowp + bj * HALF + 4) = acc[ai][bj][m][1]; } }
    }
};
struct EpiBf16P {
    static constexpr bool PERM = true, AFTER_DRAIN = false;
    bf16_t* O; int ldc;
    __device__ __forceinline__ void operator()(const f32x4 (&acc)[2][2][4][2], const Unit& u, int wr, int wc, int fr, int fq) const {
        const int row0 = u.pm * BM + wr * 64 + fr, col0 = u.pn * BM + wc * 32 + 8 * fq;
#pragma unroll
        for (int ai = 0; ai < 2; ++ai)
#pragma unroll
            for (int m = 0; m < 4; ++m) { bf16_t* rowp = O + (size_t)(row0 + ai * HALF + m * 16) * ldc + col0;
#pragma unroll
                for (int bj = 0; bj < 2; ++bj) { const f32x4 v0 = acc[ai][bj][m][0], v1 = acc[ai][bj][m][1];
                    u32x4 w; w.x = cvt_pk_bf16(v0[0], v0[1]); w.y = cvt_pk_bf16(v0[2], v0[3]); w.z = cvt_pk_bf16(v1[0], v1[1]); w.w = cvt_pk_bf16(v1[2], v1[3]);
                    *(u32x4*)(rowp + bj * HALF) = w; } }
    }
};
struct EpiBf16Slab {
    static constexpr bool PERM = true, AFTER_DRAIN = false;
    bf16_t* O; int ldc; float* slab;
    __device__ __forceinline__ void operator()(const f32x4 (&acc)[2][2][4][2], const Unit& u, int wr, int wc, int fr, int fq) const {
        if (u.part == 0) {
            const int row0 = u.pm * BM + wr * 64 + fr, col0 = u.pn * BM + wc * 32 + 8 * fq;
#pragma unroll
            for (int ai = 0; ai < 2; ++ai)
#pragma unroll
                for (int m = 0; m < 4; ++m) { bf16_t* rowp = O + (size_t)(row0 + ai * HALF + m * 16) * ldc + col0;
#pragma unroll
                    for (int bj = 0; bj < 2; ++bj) { const f32x4 v0 = acc[ai][bj][m][0], v1 = acc[ai][bj][m][1];
                        u32x4 w; w.x = cvt_pk_bf16(v0[0], v0[1]); w.y = cvt_pk_bf16(v0[2], v0[3]); w.z = cvt_pk_bf16(v1[0], v1[1]); w.w = cvt_pk_bf16(v1[2], v1[3]);
                        *(u32x4*)(rowp + bj * HALF) = w; } }
        } else {
            bf16_t* base = (bf16_t*)slab + (size_t)(u.part - 1) * (BM * BM) + (size_t)(wr * 64 + fr) * BM + wc * 32 + 8 * fq;
#pragma unroll
            for (int ai = 0; ai < 2; ++ai)
#pragma unroll
                for (int m = 0; m < 4; ++m) { bf16_t* rowp = base + (size_t)(ai * HALF + m * 16) * BM;
#pragma unroll
                    for (int bj = 0; bj < 2; ++bj) { const f32x4 v0 = acc[ai][bj][m][0], v1 = acc[ai][bj][m][1];
                        u32x4 w; w.x = cvt_pk_bf16(v0[0], v0[1]); w.y = cvt_pk_bf16(v0[2], v0[3]); w.z = cvt_pk_bf16(v1[0], v1[1]); w.w = cvt_pk_bf16(v1[2], v1[3]);
                        *(u32x4*)(rowp + bj * HALF) = w; } }
        }
    }
};
struct EpiRelu2 {
    static constexpr bool PERM = true, AFTER_DRAIN = false;
    bf16_t* O; int ldc;
    __device__ __forceinline__ void operator()(const f32x4 (&acc)[2][2][4][2], const Unit& u, int wr, int wc, int fr, int fq) const {
        const int row0 = u.pm * BM + wr * 64 + fr, col0 = u.pn * BM + wc * 32 + 8 * fq;
#pragma unroll
        for (int ai = 0; ai < 2; ++ai)
#pragma unroll
            for (int m = 0; m < 4; ++m) { bf16_t* rowp = O + (size_t)(row0 + ai * HALF + m * 16) * ldc + col0;
#pragma unroll
                for (int bj = 0; bj < 2; ++bj) { f32x4 v0 = acc[ai][bj][m][0], v1 = acc[ai][bj][m][1];
#pragma unroll
                    for (int e = 0; e < 4; ++e) { const float a = v0[e] > 0.f ? v0[e] : 0.f, b = v1[e] > 0.f ? v1[e] : 0.f; v0[e] = a * a; v1[e] = b * b; }
                    u32x4 w; w.x = cvt_pk_bf16(v0[0], v0[1]); w.y = cvt_pk_bf16(v0[2], v0[3]); w.z = cvt_pk_bf16(v1[0], v1[1]); w.w = cvt_pk_bf16(v1[2], v1[3]);
                    *(u32x4*)(rowp + bj * HALF) = w; } }
    }
};

template <class Epi, class Sched, bool ALIGN_EPI = false, bool SP2 = false>
__device__ __forceinline__ void gemm_phase(PG8_LAS unsigned char* lds, const Gemm g, const Sched& S, const Epi& E) {
    int tid_ = threadIdx.x; asm volatile("" : "+v"(tid_));
    const int tid = tid_, wid = __builtin_amdgcn_readfirstlane(tid >> 6), lane = tid & 63, wr = wid >> 2, wc = wid & 3, fr = lane & 15, fq = lane >> 4;
    const int K = g.K;
    unsigned voffA[2], voffB[2];
#pragma unroll
    for (int i = 0; i < 2; ++i) { int R, C; stage_rc(tid * 16 + i * 8192, R, C); const int Rb = Epi::PERM ? ((R & ~31) + perm32(R & 31)) : R;
        voffA[i] = (unsigned)(R * K + C) * 2u; voffB[i] = (unsigned)(Rb * K + C) * 2u; }
    const size_t kstep = (size_t)(BK * 2);
    const size_t hstep = (size_t)HALF * K * 2;
    const size_t tstep = 2 * hstep;
    const unsigned ldsw = (unsigned)wid * 1024u;
    const int aoff = lds_byte(wr * 64 + fr, fq * 8), boff = lds_byte(wc * 32 + fr, fq * 8);
#define PG8_SA(b, h) (((b) * 2 + (h)) * HTB)
#define PG8_SB(b, h) ((4 + (b) * 2 + (h)) * HTB)
#define PG8_STAGE(bufoff, gbase, voff) do { _Pragma("unroll") for (int _i = 0; _i < 2; ++_i) \
        __builtin_amdgcn_global_load_lds((const unsigned*)((const char*)(gbase) + (voff)[_i]), (PG8_LAS unsigned*)(lds + (bufoff) + ldsw + _i * 8192), 16, 0, 0); } while (0)
#define PG8_LDA(dst, b, h) do { _Pragma("unroll") for (int m = 0; m < 4; ++m) _Pragma("unroll") for (int k = 0; k < 2; ++k) dst[m][k] = *(const PG8_LAS bf16x8*)(lds + PG8_SA(b, h) + aoff + m * 2048 + k * 1024); } while (0)
#define PG8_LDB(dst, b, h) do { _Pragma("unroll") for (int n = 0; n < 2; ++n) _Pragma("unroll") for (int k = 0; k < 2; ++k) dst[n][k] = *(const PG8_LAS bf16x8*)(lds + PG8_SB(b, h) + boff + n * 2048 + k * 1024); } while (0)
#define PG8_MMA(ai, bj, At, Bt) do { __builtin_amdgcn_s_setprio(1); _Pragma("unroll") for (int m = 0; m < 4; ++m) _Pragma("unroll") for (int n = 0; n < 2; ++n) _Pragma("unroll") for (int k = 0; k < 2; ++k) \
        acc[ai][bj][m][n] = __builtin_amdgcn_mfma_f32_16x16x32_bf16(Bt[n][k], At[m][k], acc[ai][bj][m][n], 0, 0, 0); __builtin_amdgcn_s_setprio(0); } while (0)
#define PG8_WAIT_V(n) asm volatile("s_waitcnt vmcnt(" #n ")" ::: "memory")
#define PG8_WAIT_L(n) asm volatile("s_waitcnt lgkmcnt(" #n ")" ::: "memory")
#define PG8_BAR __builtin_amdgcn_s_barrier()
#define PG8_SCHED __builtin_amdgcn_sched_barrier(0)
    Unit cur, nxt; int ui = 0;
    if (!S.next(0, cur)) return;
    f32x4 acc[2][2][4][2];
#pragma unroll
    for (int a = 0; a < 2; ++a)
#pragma unroll
        for (int b = 0; b < 2; ++b)
#pragma unroll
            for (int m = 0; m < 4; ++m)
#pragma unroll
                for (int n = 0; n < 2; ++n) acc[a][b][m][n] = (f32x4){0.f, 0.f, 0.f, 0.f};
    bf16x8 At[4][2], B0[2][2], B1[2][2];
    const char* cA = (const char*)g.A + (size_t)cur.pm * tstep + (size_t)cur.kb * 2 * kstep; const char* cB = (const char*)g.Bt + (size_t)cur.pn * tstep + (size_t)cur.kb * 2 * kstep;
    S.a_ready(cur);
    if constexpr (SP2) {
        PG8_STAGE(PG8_SB(0, 0), cB, voffB); PG8_STAGE(PG8_SB(0, 1), cB + hstep, voffB); PG8_STAGE(PG8_SA(0, 0), cA, voffA); PG8_STAGE(PG8_SA(0, 1), cA + hstep, voffA);
        if (wr == 1) PG8_BAR;
        PG8_WAIT_V(2); PG8_BAR;
        PG8_STAGE(PG8_SB(1, 0), cB + kstep, voffB); PG8_STAGE(PG8_SA(1, 0), cA + kstep, voffA); PG8_STAGE(PG8_SB(1, 1), cB + hstep + kstep, voffB);
        PG8_WAIT_V(6); PG8_BAR;
    } else {
        PG8_STAGE(PG8_SB(0, 0), cB, voffB); PG8_STAGE(PG8_SA(0, 0), cA, voffA); PG8_STAGE(PG8_SB(0, 1), cB + hstep, voffB); PG8_STAGE(PG8_SA(0, 1), cA + hstep, voffA);
        if (wr == 1) PG8_BAR;
        PG8_WAIT_V(4); PG8_BAR;
        PG8_STAGE(PG8_SB(1, 0), cB + kstep, voffB); PG8_STAGE(PG8_SA(1, 0), cA + kstep, voffA); PG8_STAGE(PG8_SB(1, 1), cB + hstep + kstep, voffB);
        PG8_WAIT_V(6); PG8_BAR;
    }
    for (;;) {
        const bool has_next = S.next(ui + 1, nxt);
        const char* nA = has_next ? (const char*)g.A + (size_t)nxt.pm * tstep + (size_t)nxt.kb * 2 * kstep : cA; const char* nB = has_next ? (const char*)g.Bt + (size_t)nxt.pn * tstep + (size_t)nxt.kb * 2 * kstep : cB;
        const int nt = 2 * cur.nk;
        for (int t = 0; t < nt; t += 2) {
            const bool last = (t == nt - 2);
            const char* a1 = cA + (size_t)(t + 1) * kstep;
            const char* a2 = last ? nA : cA + (size_t)(t + 2) * kstep; const char* b2 = last ? nB : cB + (size_t)(t + 2) * kstep;
            const char* a3 = a2 + kstep; const char* b3 = b2 + kstep;
            if (last && has_next) S.a_ready(nxt);
            if constexpr (SP2) {
            PG8_LDB(B0, 0, 0); PG8_LDB(B1, 0, 1); PG8_SCHED; PG8_LDA(At, 0, 0); PG8_STAGE(PG8_SA(1, 1), a1 + hstep, voffA);
            PG8_WAIT_V(8); PG8_WAIT_L(0); PG8_BAR; PG8_MMA(0, 0, At, B0); PG8_MMA(0, 1, At, B1); PG8_BAR; PG8_SCHED;
            PG8_LDA(At, 0, 1); PG8_STAGE(PG8_SB(0, 0), b2, voffB); PG8_STAGE(PG8_SB(0, 1), b2 + hstep, voffB); PG8_STAGE(PG8_SA(0, 0), a2, voffA);
            PG8_WAIT_V(8); PG8_WAIT_L(0); PG8_BAR; PG8_MMA(1, 0, At, B0); PG8_MMA(1, 1, At, B1); PG8_BAR; PG8_SCHED;
            PG8_LDB(B0, 1, 0); PG8_LDB(B1, 1, 1); PG8_SCHED; PG8_LDA(At, 1, 0); PG8_STAGE(PG8_SA(0, 1), a2 + hstep, voffA);
            PG8_WAIT_V(8); PG8_WAIT_L(0); PG8_BAR; PG8_MMA(0, 0, At, B0); PG8_MMA(0, 1, At, B1); PG8_BAR; PG8_SCHED;
            PG8_LDA(At, 1, 1); PG8_STAGE(PG8_SB(1, 0), b3, voffB); PG8_STAGE(PG8_SB(1, 1), b3 + hstep, voffB); PG8_STAGE(PG8_SA(1, 0), a3, voffA);
            PG8_WAIT_V(8); PG8_WAIT_L(0); PG8_BAR; PG8_MMA(1, 0, At, B0); PG8_MMA(1, 1, At, B1); PG8_BAR; PG8_SCHED;
            } else {
            PG8_LDB(B0, 0, 0); PG8_SCHED; PG8_LDA(At, 0, 0); PG8_STAGE(PG8_SA(1, 1), a1 + hstep, voffA);
            PG8_WAIT_L(8); PG8_BAR; PG8_WAIT_L(0); PG8_MMA(0, 0, At, B0); PG8_BAR; PG8_SCHED;
            PG8_LDB(B1, 0, 1); PG8_STAGE(PG8_SB(0, 0), b2, voffB);
            PG8_BAR; PG8_WAIT_L(0); PG8_MMA(0, 1, At, B1); PG8_BAR;
            PG8_LDA(At, 0, 1); PG8_STAGE(PG8_SA(0, 0), a2, voffA);
            PG8_BAR; PG8_WAIT_L(0); PG8_MMA(1, 0, At, B0); PG8_BAR; PG8_SCHED;
            PG8_STAGE(PG8_SB(0, 1), b2 + hstep, voffB);
            PG8_WAIT_V(6); PG8_BAR; PG8_MMA(1, 1, At, B1); PG8_BAR;
            PG8_LDB(B0, 1, 0); PG8_SCHED; PG8_LDA(At, 1, 0); PG8_STAGE(PG8_SA(0, 1), a2 + hstep, voffA);
            PG8_WAIT_L(8); PG8_BAR; PG8_WAIT_L(0); PG8_MMA(0, 0, At, B0); PG8_BAR; PG8_SCHED;
            PG8_LDB(B1, 1, 1); PG8_STAGE(PG8_SB(1, 0), b3, voffB);
            PG8_BAR; PG8_WAIT_L(0); PG8_MMA(0, 1, At, B1); PG8_BAR;
            PG8_LDA(At, 1, 1); PG8_STAGE(PG8_SA(1, 0), a3, voffA);
            PG8_BAR; PG8_WAIT_L(0); PG8_MMA(1, 0, At, B0); PG8_BAR; PG8_SCHED;
            PG8_STAGE(PG8_SB(1, 1), b3 + hstep, voffB);
            PG8_WAIT_V(6); PG8_BAR; PG8_MMA(1, 1, At, B1); PG8_BAR;
            }
        }
        if constexpr (ALIGN_EPI) { if (wr == 0) PG8_BAR; }
        if constexpr (!Epi::AFTER_DRAIN) { E(acc, cur, wr, wc, fr, fq); S.done(cur); }
        if (!has_next) break;
#pragma unroll
        for (int a = 0; a < 2; ++a)
#pragma unroll
            for (int b = 0; b < 2; ++b)
#pragma unroll
                for (int m = 0; m < 4; ++m)
#pragma unroll
                    for (int n = 0; n < 2; ++n) acc[a][b][m][n] = (f32x4){0.f, 0.f, 0.f, 0.f};
        cur = nxt; cA = nA; cB = nB; ++ui;
        if constexpr (ALIGN_EPI) { if (wr == 1) PG8_BAR; }
    }
    PG8_WAIT_V(0);
    if constexpr (!ALIGN_EPI) { if (wr == 0) PG8_BAR; }
    PG8_BAR;
    if constexpr (Epi::AFTER_DRAIN) { E.fused(acc, cur, wr, wc, fr, fq, lds, wid, lane); S.done(cur); }
#undef PG8_SA
#undef PG8_SB
#undef PG8_STAGE
#undef PG8_LDA
#undef PG8_LDB
#undef PG8_MMA
#undef PG8_WAIT_V
#undef PG8_WAIT_L
#undef PG8_BAR
#undef PG8_SCHED
}
}

#define GAS __attribute__((address_space(1)))
#define LAS __attribute__((address_space(3)))
typedef unsigned short bf16;
typedef unsigned v4u __attribute__((ext_vector_type(4)));
typedef float f32x4 __attribute__((ext_vector_type(4)));
typedef float f32x16 __attribute__((ext_vector_type(16)));
typedef short bf16x8 __attribute__((ext_vector_type(8)));
typedef GAS unsigned gu32;
#define RLX_AGENT __ATOMIC_RELAXED, __HIP_MEMORY_SCOPE_AGENT
#define LDS_WAIT() asm volatile("s_waitcnt lgkmcnt(0)" ::: "memory")
#define VM_WAIT() asm volatile("s_waitcnt vmcnt(0)" ::: "memory")
typedef float f32x2_c __attribute__((ext_vector_type(2))); typedef __bf16 bf16x2_c __attribute__((ext_vector_type(2)));
__device__ __forceinline__ unsigned pk2(float lo, float hi) { const f32x2_c v = {lo, hi}; return __builtin_bit_cast(unsigned, __builtin_convertvector(v, bf16x2_c)); }
__device__ __forceinline__ unsigned f2bf(float f) { return pk2(f, 0.f) & 0xffffu; }
__device__ __forceinline__ float bf2f(bf16 v) { return __builtin_bit_cast(float, (unsigned)v << 16); }

#define XB_TMO      128
#define XB_XCNT(j)  (256  + 64 * (j))
#define XB_XSUB(j)  (1280 + 64 * (j))
#define XB_XGEN(j)  (2304 + 64 * (j))
#define XB_TOP      3328
#define XB_TOPGEN   3392
#define XCD_BAR_WORDS 3456
#define XB_SPIN_CAP (1u << 18)

__device__ __forceinline__ unsigned xb_ld(unsigned* p)              { return __hip_atomic_load(p, __ATOMIC_RELAXED, __HIP_MEMORY_SCOPE_AGENT); }
__device__ __forceinline__ unsigned xb_add(unsigned* p, unsigned v) { return __hip_atomic_fetch_add(p, v, __ATOMIC_RELAXED, __HIP_MEMORY_SCOPE_AGENT); }
__device__ __forceinline__ unsigned xb_xcc_id() { return (unsigned)__builtin_amdgcn_s_getreg((3 << 11) | 20) & 0xFu; }
#define XB_SPIN(cond, bar) do { unsigned _sp = 0; while (cond) { __builtin_amdgcn_s_sleep(1); \
    if ((++_sp & 255u) == 0u) { if (xb_ld(&(bar)[XB_TMO])) break; if (_sp > XB_SPIN_CAP) { atomicAdd(&(bar)[XB_TMO], 1u); break; } } } } while (0)

struct XcdBarrier {
    unsigned* bar; unsigned x;
    volatile LAS unsigned* st;
};

__device__ __forceinline__ XcdBarrier xcd_barrier_post(unsigned* bar, volatile LAS unsigned* st) {
    XcdBarrier b; b.bar = bar; b.x = xb_xcc_id(); b.st = st;
    if (threadIdx.x == 0) (void)xb_add(&bar[XB_XCNT(b.x)], 1u);
    return b;
}
__device__ __forceinline__ void xcd_barrier_complete(unsigned* bar, unsigned x, unsigned& nloc, unsigned& nx) {
    const unsigned G = gridDim.x * gridDim.y * gridDim.z;
    unsigned sum, cnt, mine, sp = 0u;
    for (;;) {
        sum = 0u; cnt = 0u; mine = 0u;
#pragma unroll
        for (unsigned j = 0; j < 16; ++j) { const unsigned c = xb_ld(&bar[XB_XCNT(j)]); sum += c; cnt += (c > 0u) ? 1u : 0u; mine = (j == x) ? c : mine; }
        if (sum == G) break;
        __builtin_amdgcn_s_sleep(1);
        if ((++sp & 255u) == 0u) { if (xb_ld(&bar[XB_TMO])) break; if (sp > XB_SPIN_CAP) { atomicAdd(&bar[XB_TMO], 1u); break; } }
    }
    nloc = mine > 0u ? mine : 1u; nx = cnt > 0u ? cnt : 1u;
}

__device__ __forceinline__ void xcd_barrier(const XcdBarrier& b) {
    asm volatile("s_waitcnt vmcnt(0)" ::: "memory");
    __syncthreads();
    if (threadIdx.x == 0) {
        unsigned* bar = b.bar;
        __builtin_amdgcn_s_waitcnt(0);
        unsigned nloc = b.st[0], nx = b.st[1];
        if (nloc == 0u) { xcd_barrier_complete(bar, b.x, nloc, nx); b.st[0] = nloc; b.st[1] = nx; }
        const unsigned old = xb_add(&bar[XB_XSUB(b.x)], 1u);
        const unsigned gen = old / nloc;
        if (old + 1u == (gen + 1u) * nloc) {
            __builtin_amdgcn_fence(__ATOMIC_RELEASE, "agent");
            asm volatile("s_waitcnt vmcnt(0)" ::: "memory");
            (void)xb_add(&bar[XB_TOP], 1u);
        }
        XB_SPIN(xb_ld(&bar[XB_TOP]) < (gen + 1u) * nx, bar);
        __builtin_amdgcn_fence(__ATOMIC_ACQUIRE, "agent");
        asm volatile("s_waitcnt vmcnt(0)" ::: "memory");
    }
    __syncthreads();
}

__device__ __forceinline__ void xcd_arrive(const XcdBarrier& b) {
    asm volatile("s_waitcnt vmcnt(0)" ::: "memory");
    __syncthreads();
    if (threadIdx.x == 0) {
        unsigned* bar = b.bar;
        __builtin_amdgcn_s_waitcnt(0);
        unsigned nloc = b.st[0], nx = b.st[1];
        if (nloc == 0u) { xcd_barrier_complete(bar, b.x, nloc, nx); b.st[0] = nloc; b.st[1] = nx; }
        const unsigned old = xb_add(&bar[XB_XSUB(b.x)], 1u);
        const unsigned gen = old / nloc;
        if (old + 1u == (gen + 1u) * nloc) {
            __builtin_amdgcn_fence(__ATOMIC_RELEASE, "agent");
            asm volatile("s_waitcnt vmcnt(0)" ::: "memory");
            (void)xb_add(&bar[XB_TOP], 1u);
        }
        b.st[2] = (gen + 1u) * nx;
    }
    __syncthreads();
}
__device__ __forceinline__ void xcd_wait_wave(const XcdBarrier& b) {
    const unsigned target = b.st[2];
    XB_SPIN((unsigned)__builtin_amdgcn_readfirstlane(xb_ld(&b.bar[XB_TOP])) < target, b.bar);
    __builtin_amdgcn_fence(__ATOMIC_ACQUIRE, "agent");
    asm volatile("s_waitcnt vmcnt(0)" ::: "memory");
}
__device__ __forceinline__ void cnt_arrive(unsigned* cnt) {
    asm volatile("s_waitcnt vmcnt(0)" ::: "memory");
    __syncthreads();
    if (threadIdx.x == 0) { __builtin_amdgcn_fence(__ATOMIC_RELEASE, "agent"); asm volatile("s_waitcnt vmcnt(0)" ::: "memory"); (void)xb_add(cnt, 1u); }
}
__device__ __forceinline__ void cnt_wait_wave(unsigned* cnt, unsigned need, unsigned* bar) {
    XB_SPIN((unsigned)__builtin_amdgcn_readfirstlane(xb_ld(cnt)) < need, bar);
    __builtin_amdgcn_fence(__ATOMIC_ACQUIRE, "agent");
    asm volatile("s_waitcnt vmcnt(0)" ::: "memory");
}

struct OneUnitOrder {
    pg8::Unit u0;
    __device__ __forceinline__ bool next(int i, pg8::Unit& u) const { if (i != 0) return false; u = u0; return true; }
    __device__ __forceinline__ void a_ready(const pg8::Unit&) const {}
    __device__ __forceinline__ void done(const pg8::Unit&) const {}
};
struct DownOrder {
    pg8::StaticOrder so; int slice; const XcdBarrier* b; unsigned* cntB;
    __device__ __forceinline__ bool next(int i, pg8::Unit& u) const {
        if (i == 0) return so.next(0, u);
        if (i != 1 || slice < 0) return false;
        const int e = slice >> 3, sl = slice & 7; u.pm = 64 + (e >> 2); u.pn = e & 3; u.nk = so.nkp / 8; u.kb = sl * u.nk; u.part = 1 + slice; return true;
    }
    __device__ __forceinline__ void a_ready(const pg8::Unit& u) const {
        if (threadIdx.x < 64) { if (u.part == 0) xcd_wait_wave(*b); else cnt_wait_wave(cntB, 80u, b->bar); }
        asm volatile("" ::: "memory"); __builtin_amdgcn_s_barrier(); asm volatile("" ::: "memory");
    }
    __device__ __forceinline__ void done(const pg8::Unit&) const {}
};

constexpr int NWAVES = 8;
constexpr int D = 1024, TP = 8208, NBATCH = 2, SEQ = 8192, NMETA = 16;
constexpr int MP = NBATCH * TP;
constexpr int MSAMP = 1024;
constexpr int MREAL = MP + MSAMP;
constexpr int MPAD = 17664;
constexpr int FF = 4096, NPROJ = 2560, AW = 512, HD = 64;
constexpr int DEC_B = 128, NPAGES = 16;
constexpr int NCHUNK = 129;
constexpr float RMS_EPS = 1e-6f;
constexpr float LOG2E = 1.4426950408889634f;
constexpr float QSCALE = 0.125f * LOG2E;

constexpr size_t O_YP = 0, O_YS = O_YP + (size_t)NBATCH * SEQ * D, O_KP = O_YS + (size_t)MSAMP * D, O_VP = O_KP + (size_t)MP * AW, O_HP = O_VP + (size_t)MP * AW,
                 O_CP = O_HP + NBATCH * AW, O_KS = O_CP + NBATCH * 3 * AW, O_VS = O_KS + (size_t)MSAMP * AW, O_HS = O_VS + (size_t)MSAMP * AW, O_CS = O_HS + DEC_B * AW, O_END = O_CS + DEC_B * 3 * AW;
static_assert(O_END == 35950592, "output size");

constexpr size_t MiB = 1u << 20;
constexpr size_t WS_CTL = 0, CTL_ZERO_BYTES = 1 * MiB;
constexpr size_t WS_WIN = 2 * MiB, WS_WOUT = 8 * MiB, WS_WUP = 10 * MiB, WS_WDN = 18 * MiB;
constexpr size_t WS_XN = 32 * MiB;
constexpr size_t WS_Q = 68 * MiB, WS_SPLIT = 18 * MiB;
constexpr size_t WS_K = WS_Q + WS_SPLIT, WS_V = WS_Q + 2 * WS_SPLIT, WS_XL = WS_Q + 3 * WS_SPLIT, WS_GATE = WS_Q + 4 * WS_SPLIT;
constexpr size_t WS_MIX = 158 * MiB;
constexpr size_t WS_MIXED = 194 * MiB;
constexpr size_t WS_X1 = 266 * MiB;
constexpr size_t WS_XN2 = 338 * MiB;
constexpr size_t WS_H = 374 * MiB;
constexpr size_t WS_DOWN = 514 * MiB;
constexpr size_t WS_HLOC = 586 * MiB, WS_ACUM = 620 * MiB;
constexpr size_t WS_ATOT = 654 * MiB, WS_BTOT = 656 * MiB;
constexpr size_t WS_OPART = 658 * MiB, WS_RPART = 662 * MiB, WS_SLAB = 664 * MiB, WS_RS0 = 728 * MiB, WS_END = 729 * MiB;
static_assert((size_t)MPAD * D * 2 <= 36 * MiB && (size_t)MPAD * 512 * 2 <= WS_SPLIT && (size_t)MPAD * D * 4 <= 72 * MiB && (size_t)MPAD * FF * 2 <= 140 * MiB && (size_t)MP * 512 * 4 <= 34 * MiB, "ws map");
constexpr int CW_BAR = 4096, CW_CNTB = 8192, CW_CNTC = 8256;

constexpr int RING_BYTES = 131072;
constexpr int LDSCTL_OFF = RING_BYTES, MISC_OFF = LDSCTL_OFF + 320;
constexpr int LDS_BYTES = 163840;

__device__ __forceinline__ float wave_sum(float v) {
#pragma unroll
    for (int o = 1; o < 64; o <<= 1) v += __shfl_xor(v, o);
    return v;
}
__device__ __forceinline__ void p0_transpose_item(const float* W, int K, int N, bf16* WT, int row_off, LAS float* scr, int item, int lane) {
    const int nblk = N / 32, kb = item / nblk, nb = item % nblk, k0 = 64 * kb, n0 = 32 * nb;
    float wv[32];
#pragma unroll
    for (int i = 0; i < 32; ++i) { const int kk = 2 * i + (lane >> 5); wv[i] = __builtin_nontemporal_load(W + (size_t)(k0 + kk) * N + n0 + (lane & 31)); }
#pragma unroll
    for (int i = 0; i < 32; ++i) { const int kk = 2 * i + (lane >> 5); scr[kk * 33 + (lane & 31)] = wv[i]; }
    LDS_WAIT(); asm volatile("" ::: "memory");
    const int c = lane & 7;
#pragma unroll
    for (int j = 0; j < 4; ++j) { const int n = (lane >> 3) + 8 * j; const LAS float* s = scr + (8 * c) * 33 + n;
        v4u o; o.x = pk2(s[0 * 33], s[1 * 33]); o.y = pk2(s[2 * 33], s[3 * 33]); o.z = pk2(s[4 * 33], s[5 * 33]); o.w = pk2(s[6 * 33], s[7 * 33]);
        *(GAS v4u*)(WT + (size_t)(row_off + n0 + n) * K + k0 + 8 * c) = o; }
    LDS_WAIT(); asm volatile("" ::: "memory");
}
__device__ __forceinline__ const float* xrow_ptr(int r, const float* xp, const float* xs, const float* meta) {
    if (r < MP) { const int b = r >= TP ? 1 : 0; const int t = r - b * TP; return t < NMETA ? meta + (size_t)t * D : xp + ((size_t)b * SEQ + (t - NMETA)) * D; }
    return xs + (size_t)(r - MP) * D;
}
__device__ __forceinline__ float dot4(f32x4 a) { return (a.x * a.x + a.y * a.y) + (a.z * a.z + a.w * a.w); }
__device__ __forceinline__ f32x4 unpack4(unsigned long long w) { const unsigned lo = (unsigned)w, hi = (unsigned)(w >> 32); return (f32x4){__builtin_bit_cast(float, lo << 16), __builtin_bit_cast(float, lo & 0xffff0000u), __builtin_bit_cast(float, hi << 16), __builtin_bit_cast(float, hi & 0xffff0000u)}; }
__device__ __forceinline__ unsigned long long pack4(f32x4 v) { return (unsigned long long)pk2(v.x, v.y) | ((unsigned long long)pk2(v.z, v.w) << 32); }
__device__ __forceinline__ void rms_row_to_bf16(const float* xrow, const float* g, bf16* orow, float* rs, int lane) {
    const GAS f32x4* xr = (const GAS f32x4*)xrow + lane; const GAS f32x4* gr = (const GAS f32x4*)g + lane;
    f32x4 v[4]; float s = 0.f;
#pragma unroll
    for (int j = 0; j < 4; ++j) { v[j] = xr[64 * j]; s += dot4(v[j]); }
    const float sd = sqrtf(wave_sum(s) * (1.f / D) + RMS_EPS), rstd = 1.0f / sd;
    if (lane == 0) *rs = sd;
    GAS unsigned long long* o8 = (GAS unsigned long long*)orow + lane;
#pragma unroll
    for (int j = 0; j < 4; ++j) { const f32x4 gg = gr[64 * j]; o8[64 * j] = pack4(v[j] * rstd * gg); }
}
__device__ __forceinline__ float sigmoidf_(float x) { return __builtin_amdgcn_rcpf(1.0f + __expf(-x)); }
__device__ __forceinline__ float gelu_tanh(float x) {
    const float t = x * x;
    const float z = x * __builtin_fmaf(t, -2.f * 0.7978845608028654f * 0.044715f * 1.4426950408889634f, -2.f * 0.7978845608028654f * 1.4426950408889634f);
    return x * __builtin_amdgcn_rcpf(1.0f + __builtin_amdgcn_exp2f(z));
}

namespace sb {
typedef short s16x4 __attribute__((ext_vector_type(4)));
typedef unsigned u32x4 __attribute__((ext_vector_type(4)));
typedef LAS const char* lds_cptr;
constexpr int KP = 512;
constexpr int NSLOT = 3, SLOTB = 8192;
constexpr int LDS_K = 0, LDS_V = NSLOT * SLOTB, LDS_OST = 2 * NSLOT * SLOTB, ATT_LDS = LDS_OST + NWAVES * 4096;
__device__ __forceinline__ int crow(int r, int hi) { return (r & 3) + 8 * (r >> 2) + 4 * hi; }
__device__ __forceinline__ void glds16(const void* gsrc, unsigned lds_dst) { unsigned keep;
    asm volatile("s_mov_b32 %0, m0\n\ts_mov_b32 m0, %2\n\ts_nop 0\n\tglobal_load_lds_dwordx4 %1, off\n\ts_mov_b32 m0, %0" : "=&s"(keep) : "v"(gsrc), "s"(lds_dst) : "memory"); }
__device__ __forceinline__ void glds16_nt(const void* gsrc, unsigned lds_dst) { unsigned keep;
    asm volatile("s_mov_b32 %0, m0\n\ts_mov_b32 m0, %2\n\ts_nop 0\n\tglobal_load_lds_dwordx4 %1, off nt\n\ts_mov_b32 m0, %0" : "=&s"(keep) : "v"(gsrc), "s"(lds_dst) : "memory"); }
__device__ __forceinline__ void glds2_k(const void* sb, const void* sb2, unsigned v, unsigned lds_dst) { unsigned keep;
    asm volatile("s_mov_b32 %0, m0\n\ts_mov_b32 m0, %4\n\ts_nop 0\n\tglobal_load_lds_dwordx4 %1, %2\n\ts_add_u32 m0, m0, 0x400\n\ts_nop 0\n\tglobal_load_lds_dwordx4 %1, %3\n\ts_mov_b32 m0, %0"
                 : "=&s"(keep) : "v"(v), "s"(sb), "s"(sb2), "s"(lds_dst) : "memory", "scc"); }
template <int STEP> __device__ __forceinline__ void glds2_g(const void* sb, const void* sb2, unsigned va, unsigned vb, unsigned lds_dst) { unsigned keep;
    asm volatile("s_mov_b32 %0, m0\n\ts_mov_b32 m0, %5\n\ts_nop 0\n\tglobal_load_lds_dwordx4 %1, %3\n\ts_add_u32 m0, m0, %6\n\ts_nop 0\n\tglobal_load_lds_dwordx4 %2, %4\n\ts_mov_b32 m0, %0"
                 : "=&s"(keep) : "v"(va), "v"(vb), "s"(sb), "s"(sb2), "s"(lds_dst), "n"(STEP) : "memory", "scc"); }
__device__ __forceinline__ void glds8_nt(const void* sb, const unsigned (&vo)[8], unsigned lds_dst) { unsigned keep;
    asm volatile("s_mov_b32 %0, m0\n\ts_mov_b32 m0, %10\n\ts_nop 0\n\tglobal_load_lds_dwordx4 %1, %9 nt\n\ts_add_u32 m0, m0, 0x400\n\ts_nop 0\n\tglobal_load_lds_dwordx4 %2, %9 nt\n\ts_add_u32 m0, m0, 0x400\n\ts_nop 0\n\tglobal_load_lds_dwordx4 %3, %9 nt\n\ts_add_u32 m0, m0, 0x400\n\ts_nop 0\n\tglobal_load_lds_dwordx4 %4, %9 nt\n\ts_add_u32 m0, m0, 0x400\n\ts_nop 0\n\tglobal_load_lds_dwordx4 %5, %9 nt\n\ts_add_u32 m0, m0, 0x400\n\ts_nop 0\n\tglobal_load_lds_dwordx4 %6, %9 nt\n\ts_add_u32 m0, m0, 0x400\n\ts_nop 0\n\tglobal_load_lds_dwordx4 %7, %9 nt\n\ts_add_u32 m0, m0, 0x400\n\ts_nop 0\n\tglobal_load_lds_dwordx4 %8, %9 nt\n\ts_mov_b32 m0, %0"
                 : "=&s"(keep) : "v"(vo[0]), "v"(vo[1]), "v"(vo[2]), "v"(vo[3]), "v"(vo[4]), "v"(vo[5]), "v"(vo[6]), "v"(vo[7]), "s"(sb), "s"(lds_dst) : "memory", "scc"); }
__device__ __forceinline__ void glds2_v(const void* sb, const void* sb2, unsigned va, unsigned vb, unsigned lds_dst) { unsigned keep;
    asm volatile("s_mov_b32 %0, m0\n\ts_mov_b32 m0, %5\n\ts_nop 0\n\tglobal_load_lds_dwordx4 %1, %3\n\ts_add_u32 m0, m0, 0x400\n\ts_nop 0\n\tglobal_load_lds_dwordx4 %2, %4\n\ts_mov_b32 m0, %0"
                 : "=&s"(keep) : "v"(va), "v"(vb), "s"(sb), "s"(sb2), "s"(lds_dst) : "memory", "scc"); }
__device__ __forceinline__ float fmul_s(float a, float b) { float r; asm("v_mul_f32_e32 %0, %1, %2" : "=v"(r) : "v"(a), "v"(b)); return r; }
typedef float f32x2_t __attribute__((ext_vector_type(2))); typedef __bf16 bf16x2_t __attribute__((ext_vector_type(2)));
__device__ __forceinline__ unsigned cvtpk_s(float lo, float hi) { f32x2_t v = {lo, hi}; bf16x2_t b = __builtin_convertvector(v, bf16x2_t); return __builtin_bit_cast(unsigned, b); }
#define SB_WAIT_BAR(N) asm volatile("s_waitcnt vmcnt(" #N ") lgkmcnt(0)\n\ts_barrier" ::: "memory")

template <int NHALF, bool MASK>
__device__ __forceinline__ void sb_step(f32x16 (&p)[NHALF], float& rinv, int hi, int klo, int khi, u32x4 (&pw)[2 * NHALF]) {
#pragma unroll
    for (int h = 0; h < NHALF; ++h)
#pragma unroll
        for (int r = 0; r < 16; ++r) { float e = __builtin_amdgcn_exp2f(p[h][r]); if (MASK) { const int k = crow(r, hi) + 32 * h; e = (k >= klo && k < khi) ? e : 0.f; } p[h][r] = e; }
    float tg[4 * NHALF], pe[NHALF][16];
#pragma unroll
    for (int h = 0; h < NHALF; ++h)
#pragma unroll
        for (int g = 0; g < 4; ++g) { const float c0 = 1.f + p[h][4 * g], c1 = 1.f + p[h][4 * g + 1], c2 = 1.f + p[h][4 * g + 2], c3 = 1.f + p[h][4 * g + 3];
            pe[h][4 * g] = 1.f; pe[h][4 * g + 1] = c0; pe[h][4 * g + 2] = fmul_s(c0, c1); pe[h][4 * g + 3] = fmul_s(pe[h][4 * g + 2], c2); tg[4 * h + g] = fmul_s(pe[h][4 * g + 3], c3); }
    float E = 1.f, gp[4 * NHALF];
#pragma unroll
    for (int m = 0; m < 4 * NHALF; ++m) { auto rr = __builtin_amdgcn_permlane32_swap(__float_as_uint(tg[m]), __float_as_uint(tg[m]), false, false);
        const float ev = __uint_as_float(rr[0]), od = __uint_as_float(rr[1]);
        gp[m] = hi ? E * ev : E; E = E * (ev * od); }
    rinv = rinv * __builtin_amdgcn_rcpf(E);
#pragma unroll
    for (int m = 0; m < 4 * NHALF; ++m) gp[m] *= rinv;
#pragma unroll
    for (int h = 0; h < NHALF; ++h) {
#pragma unroll
        for (int g = 0; g < 4; ++g) { const float G = gp[4 * h + g];
            p[h][4 * g] = fmul_s(p[h][4 * g], G); p[h][4 * g + 1] = fmul_s(p[h][4 * g + 1], fmul_s(G, pe[h][4 * g + 1])); p[h][4 * g + 2] = fmul_s(p[h][4 * g + 2], fmul_s(G, pe[h][4 * g + 2])); p[h][4 * g + 3] = fmul_s(p[h][4 * g + 3], fmul_s(G, pe[h][4 * g + 3])); }
        pw[2 * h]     = (u32x4){cvtpk_s(p[h][0], p[h][1]), cvtpk_s(p[h][2], p[h][3]), cvtpk_s(p[h][4], p[h][5]), cvtpk_s(p[h][6], p[h][7])};
        pw[2 * h + 1] = (u32x4){cvtpk_s(p[h][8], p[h][9]), cvtpk_s(p[h][10], p[h][11]), cvtpk_s(p[h][12], p[h][13]), cvtpk_s(p[h][14], p[h][15])};
    }
}

__device__ __forceinline__ void qkt64(f32x16& p0, f32x16& p1, lds_cptr kslot, const bf16x8* qr, const f32x16& cinit, int r32, int hi) {
    lds_cptr kb = kslot + hi * 1024 + r32 * 16;
#pragma unroll
    for (int d0 = 0; d0 < 4; ++d0) {
        const bf16x8 b0 = *(const LAS bf16x8*)(kb + d0 * 2048);
        const bf16x8 b1 = *(const LAS bf16x8*)(kb + d0 * 2048 + 512);
        if (d0 == 0) { p0 = __builtin_amdgcn_mfma_f32_32x32x16_bf16(b0, qr[0], cinit, 0, 0, 0); p1 = __builtin_amdgcn_mfma_f32_32x32x16_bf16(b1, qr[0], cinit, 0, 0, 0); }
        else { p0 = __builtin_amdgcn_mfma_f32_32x32x16_bf16(b0, qr[d0], p0, 0, 0, 0); p1 = __builtin_amdgcn_mfma_f32_32x32x16_bf16(b1, qr[d0], p1, 0, 0, 0); } }
}
__device__ __forceinline__ void pv64(f32x16* o, int vb, bf16x8 pa0, bf16x8 pa1, bf16x8 pa2, bf16x8 pa3) {
#pragma unroll
    for (int d0 = 0; d0 < 2; ++d0) { s16x4 lo[4], hi[4];
#pragma unroll
        for (int ks = 0; ks < 4; ++ks) {
            asm volatile("ds_read_b64_tr_b16 %0,%1 offset:%c2" : "=&v"(lo[ks]) : "v"(vb), "i"(d0 * 4096 + ks * 1024) : "memory");
            asm volatile("ds_read_b64_tr_b16 %0,%1 offset:%c2" : "=&v"(hi[ks]) : "v"(vb), "i"(d0 * 4096 + ks * 1024 + 512) : "memory"); }
        asm volatile("s_waitcnt lgkmcnt(0)" ::: "memory"); __builtin_amdgcn_sched_barrier(0);
#define SB_PK(k) (bf16x8){lo[k][0], lo[k][1], lo[k][2], lo[k][3], hi[k][0], hi[k][1], hi[k][2], hi[k][3]}
        o[d0] = __builtin_amdgcn_mfma_f32_32x32x16_bf16(pa0, SB_PK(0), o[d0], 0, 0, 0);
        o[d0] = __builtin_amdgcn_mfma_f32_32x32x16_bf16(pa1, SB_PK(1), o[d0], 0, 0, 0);
        o[d0] = __builtin_amdgcn_mfma_f32_32x32x16_bf16(pa2, SB_PK(2), o[d0], 0, 0, 0);
        o[d0] = __builtin_amdgcn_mfma_f32_32x32x16_bf16(pa3, SB_PK(3), o[d0], 0, 0, 0);
#undef SB_PK
    }
}

__device__ __forceinline__ void attn_unit(LAS unsigned char* shm, int b, int h, int qbase, const bf16* Q, const bf16* K, const bf16* V, bf16* MIX, float biasl2) {
    const int tid = threadIdx.x, lane = tid & 63, r32 = lane & 31, hi = lane >> 5; const int wid = __builtin_amdgcn_readfirstlane(tid >> 6);
    const long rowbase = (long)b * TP;
    const int qlo = qbase + 32 * wid, qp = qlo + r32;
    const int qpos = (qp - 48) < 0 ? 0 : (qp - 48);
    const bf16* Qrow = Q + (rowbase + qpos) * KP + h * HD;
    const bf16* Kh = K + rowbase * KP + h * HD; const bf16* Vh = V + rowbase * KP + h * HD;
    const unsigned lds0 = (unsigned)(uintptr_t)shm;
    const unsigned kdst = lds0 + LDS_K + wid * 1024, vdst = lds0 + LDS_V + wid * 1024;
#define SB_DMA_KV(t, slot) do { int kr_ = (t) * 64 + lane - 48; kr_ = kr_ < 0 ? 0 : kr_; int vr_ = (t) * 64 + 16 * (wid & 3) + (lane >> 2) - 48; vr_ = vr_ < 0 ? 0 : vr_; \
        glds16(Kh + (long)kr_ * KP + wid * 8, (unsigned)__builtin_amdgcn_readfirstlane(kdst + (slot))); \
        glds16(Vh + (long)vr_ * KP + (wid >> 2) * 32 + (lane & 3) * 8, (unsigned)__builtin_amdgcn_readfirstlane(vdst + (slot))); } while (0)
    const int t0 = (qbase + 255) >> 6;
    SB_DMA_KV(t0, 0); if (t0 >= 1) SB_DMA_KV(t0 - 1, SLOTB);
    bf16x8 qr[4];
#pragma unroll
    for (int d0 = 0; d0 < 4; ++d0) qr[d0] = *(const bf16x8*)(Qrow + d0 * 16 + hi * 8);
    f32x16 o[2]; o[0] = f32x16{}; o[1] = f32x16{}; float rinv = 1.f;
    f32x16 cinit;
#pragma unroll
    for (int r = 0; r < 16; ++r) cinit[r] = biasl2;
    const int vb0 = (int)(lds0 + LDS_V) + ((lane >> 4) & 1) * 32 + (lane & 3) * 8 + (4 * hi + ((lane & 15) >> 2)) * 64;
    const lds_cptr kbase = (lds_cptr)shm + LDS_K;
    int slot = 0;
    for (int t = t0; t >= 0; --t) {
        if (t >= 1) SB_WAIT_BAR(2); else SB_WAIT_BAR(0);
        if (t >= 2) { int s2 = slot + 2 * SLOTB; if (s2 >= NSLOT * SLOTB) s2 -= NSLOT * SLOTB; SB_DMA_KV(t - 2, s2); }
        const int kv0 = 64 * t, kvlo = kv0 < 48 ? 48 : kv0;
        if (kvlo < qlo + 31) {
            f32x16 p[2]; qkt64(p[0], p[1], kbase + slot, qr, cinit, r32, hi);
            u32x4 pw[4];
            if ((kv0 + 63 >= qlo) || t == 0) sb_step<2, true>(p, rinv, hi, t == 0 ? 48 : 0, qp - kv0, pw);
            else sb_step<2, false>(p, rinv, hi, 0, 64, pw);
            pv64(o, vb0 + slot, __builtin_bit_cast(bf16x8, pw[0]), __builtin_bit_cast(bf16x8, pw[1]), __builtin_bit_cast(bf16x8, pw[2]), __builtin_bit_cast(bf16x8, pw[3]));
        }
        slot += SLOTB; if (slot >= NSLOT * SLOTB) slot = 0;
    }
#undef SB_DMA_KV
    { int le = lane; asm volatile("" : "+v"(le));
      const int r32 = le & 31, hi = le >> 5, lane = le;
      LAS bf16* stg = (LAS bf16*)(shm + LDS_OST) + wid * 2048;
#pragma unroll
        for (int r = 0; r < 16; ++r) { const int orow = crow(r, hi);
#pragma unroll
            for (int d0 = 0; d0 < 2; ++d0) stg[orow * 64 + d0 * 32 + r32] = (bf16)f2bf(o[d0][r]); }
        asm volatile("s_waitcnt lgkmcnt(0)" ::: "memory");
#pragma unroll
        for (int i = 0; i < 4; ++i) { const int row = i * 8 + (lane >> 3), ch = lane & 7; const u32x4 v = *(const LAS u32x4*)(stg + row * 64 + ch * 8);
            const int pos = qlo + row - 48;
            if (pos >= 0) *(u32x4*)(MIX + (size_t)(rowbase + pos) * D + h * HD + ch * 8) = v; } }
    asm volatile("s_waitcnt lgkmcnt(0)\n\ts_barrier" ::: "memory");
}

typedef short v4i16_t __attribute__((ext_vector_type(4)));
#define SB_VTR(p) __builtin_bit_cast(s16x4, __builtin_amdgcn_ds_read_tr16_b64_v4i16((LAS v4i16_t*)(p)))
#define SB_PIN() __builtin_amdgcn_sched_barrier(0)
constexpr int KPIECE = 1152, SLOTK = 8 * KPIECE;
struct AttSt { f32x16 o[2]; bf16x8 qr[4]; u32x4 pw[4]; float rinv; };
typedef LAS char* lds_ptr;
template <bool MASK, bool DO_QK, bool DO_PV>
__device__ __forceinline__ void att_step(f32x16& c0, f32x16& c1, f32x16& n0, f32x16& n1, AttSt& st, const float Bf, lds_ptr kcur, const int (&kqo)[4], lds_ptr vprev, int hi, int klo, int khi) {
    bf16x8 kq[3]; s16x4 vl[3], vh[3];
#define SB_KFRAG(i) (*(const LAS bf16x8*)(kcur + kqo[(i) >> 1] + ((i) & 1) * (4 * KPIECE)))
#define SB_VI(k) ((((k) & 1) * 4) + ((k) >> 1))
#define SB_VLO(k) SB_VTR(vprev + (SB_VI(k) >> 2) * 4096 + (SB_VI(k) & 3) * 1024)
#define SB_VHI(k) SB_VTR(vprev + (SB_VI(k) >> 2) * 4096 + (SB_VI(k) & 3) * 1024 + 512)
    if (DO_QK) { kq[0] = SB_KFRAG(0); kq[1] = SB_KFRAG(1); }
    SB_PIN();
    float tg[8], pe2[8], pe3[8];
    const f32x16 zero16 = f32x16{};
#pragma unroll
    for (int gi = 0; gi < 8; ++gi) {
        f32x16& p = (gi < 4) ? c0 : c1; const int g = gi & 3, h = gi >> 2;
        float e[4];
#pragma unroll
        for (int j = 0; j < 4; ++j) { e[j] = __builtin_amdgcn_exp2f(p[4 * g + j]); if (MASK) { const int k = crow(4 * g + j, hi) + 32 * h; e[j] = (k >= klo && k < khi) ? e[j] : 0.f; } p[4 * g + j] = e[j]; }
        const float q0 = __builtin_fmaf(e[0], Bf, 1.f), q1 = __builtin_fmaf(e[1], Bf, 1.f), q2 = __builtin_fmaf(e[2], Bf, 1.f), q3 = __builtin_fmaf(e[3], Bf, 1.f);
        pe2[gi] = fmul_s(q0, q1); pe3[gi] = fmul_s(pe2[gi], q2); tg[gi] = fmul_s(pe3[gi], q3);
        if (DO_QK) { const int d0 = gi >> 1;
            if (gi + 2 < 8) kq[(gi + 2) % 3] = SB_KFRAG(gi + 2);
            if (gi & 1) n1 = __builtin_amdgcn_mfma_f32_32x32x16_bf16(kq[gi % 3], st.qr[d0], d0 == 0 ? zero16 : n1, 0, 0, 0);
            else        n0 = __builtin_amdgcn_mfma_f32_32x32x16_bf16(kq[gi % 3], st.qr[d0], d0 == 0 ? zero16 : n0, 0, 0, 0); }
        if (DO_PV && gi >= 6) { vl[(gi - 6) % 3] = SB_VLO(gi - 6); vh[(gi - 6) % 3] = SB_VHI(gi - 6); }
        SB_PIN();
    }
    float E = 1.f, gp[8];
#pragma unroll
    for (int k = 0; k < 8; ++k) {
        if (DO_PV) { const int ks = k >> 1, d0 = k & 1;
            if (k + 2 < 8) { vl[(k + 2) % 3] = SB_VLO(k + 2); vh[(k + 2) % 3] = SB_VHI(k + 2); }
            const s16x4 a = vl[k % 3], c = vh[k % 3];
            const bf16x8 vf = (bf16x8){a[0], a[1], a[2], a[3], c[0], c[1], c[2], c[3]};
            st.o[d0] = __builtin_amdgcn_mfma_f32_32x32x16_bf16(__builtin_bit_cast(bf16x8, st.pw[ks]), vf, st.o[d0], 0, 0, 0); }
        { auto rr = __builtin_amdgcn_permlane32_swap(__float_as_uint(tg[k]), __float_as_uint(tg[k]), false, false);
          const float ev = __uint_as_float(rr[0]), od = __uint_as_float(rr[1]);
          gp[k] = hi ? E * ev : E; E = E * (ev * od); }
        SB_PIN();
    }
    st.rinv = st.rinv * __builtin_amdgcn_rcpf(E);
    const float rb = st.rinv * Bf;
#pragma unroll
    for (int gi = 0; gi < 8; ++gi) { f32x16& p = (gi < 4) ? c0 : c1; const int g = gi & 3; const float G = fmul_s(gp[gi], rb);
        const float w0 = fmul_s(p[4 * g], G), w1 = fmul_s(p[4 * g + 1], fmul_s(G, __builtin_fmaf(p[4 * g], Bf, 1.f))), w2 = fmul_s(p[4 * g + 2], fmul_s(G, pe2[gi])), w3 = fmul_s(p[4 * g + 3], fmul_s(G, pe3[gi]));
        st.pw[gi >> 1][2 * (gi & 1)] = cvtpk_s(w0, w1); st.pw[gi >> 1][2 * (gi & 1) + 1] = cvtpk_s(w2, w3); }
#undef SB_KFRAG
#undef SB_VI
#undef SB_VLO
#undef SB_VHI
}

__device__ __forceinline__ void attn_unit4(LAS unsigned char* shm, int b, int h, int qbase, const bf16* Q, const bf16* K, const bf16* V, bf16* MIX, float biasl2) {
    const int tid = threadIdx.x, lane = tid & 63, r32 = lane & 31, hi = lane >> 5; const int wid = __builtin_amdgcn_readfirstlane(tid >> 6);
    const long rowbase = (long)b * TP;
    const int qlo = qbase + 32 * wid, qp = qlo + r32;
    const int qpos = (qp - 48) < 0 ? 0 : (qp - 48);
    const bf16* Qrow = Q + (rowbase + qpos) * KP + h * HD;
    const bf16* Kh = K + rowbase * KP + h * HD; const bf16* Vh = V + rowbase * KP + h * HD;
    const unsigned lds0 = (unsigned)(uintptr_t)shm;
    const unsigned kdst = lds0 + LDS_K + wid * 2048, vdst = lds0 + LDS_V + wid * 2048;
    const int vp0 = 2 * wid, vp1 = 2 * wid + 1;
#define SB_DMA_KV(t, slot) do { int kr_ = (t) * 64 + lane - 48; kr_ = kr_ < 0 ? 0 : kr_; \
        int va_ = (t) * 64 + 16 * (vp0 & 3) + (lane >> 2) - 48; va_ = va_ < 0 ? 0 : va_; int vb_ = (t) * 64 + 16 * (vp1 & 3) + (lane >> 2) - 48; vb_ = vb_ < 0 ? 0 : vb_; \
        glds16(Kh + (long)kr_ * KP + wid * 16, (unsigned)__builtin_amdgcn_readfirstlane(kdst + (slot))); \
        glds16(Kh + (long)kr_ * KP + wid * 16 + 8, (unsigned)__builtin_amdgcn_readfirstlane(kdst + 1024 + (slot))); \
        glds16(Vh + (long)va_ * KP + (vp0 >> 2) * 32 + (lane & 3) * 8, (unsigned)__builtin_amdgcn_readfirstlane(vdst + (slot))); \
        glds16(Vh + (long)vb_ * KP + (vp1 >> 2) * 32 + (lane & 3) * 8, (unsigned)__builtin_amdgcn_readfirstlane(vdst + 1024 + (slot))); } while (0)
    const int t0 = (qbase + 127) >> 6;
    SB_DMA_KV(t0, 0); if (t0 >= 1) SB_DMA_KV(t0 - 1, SLOTB);
    bf16x8 qr[4];
#pragma unroll
    for (int d0 = 0; d0 < 4; ++d0) qr[d0] = *(const bf16x8*)(Qrow + d0 * 16 + hi * 8);
    f32x16 o[2]; o[0] = f32x16{}; o[1] = f32x16{}; float rinv = 1.f;
    f32x16 cinit;
#pragma unroll
    for (int r = 0; r < 16; ++r) cinit[r] = biasl2;
    const int vb0 = (int)(lds0 + LDS_V) + ((lane >> 4) & 1) * 32 + (lane & 3) * 8 + (4 * hi + ((lane & 15) >> 2)) * 64;
    const lds_cptr kbase = (lds_cptr)shm + LDS_K;
    int slot = 0;
    for (int t = t0; t >= 0; --t) {
        if (t >= 1) SB_WAIT_BAR(4); else SB_WAIT_BAR(0);
        if (t >= 2) { int s2 = slot + 2 * SLOTB; if (s2 >= NSLOT * SLOTB) s2 -= NSLOT * SLOTB; SB_DMA_KV(t - 2, s2); }
        const int kv0 = 64 * t, kvlo = kv0 < 48 ? 48 : kv0;
        if (kvlo < qlo + 31) {
            f32x16 p[2]; qkt64(p[0], p[1], kbase + slot, qr, cinit, r32, hi);
            u32x4 pw[4];
            if ((kv0 + 63 >= qlo) || t == 0) sb_step<2, true>(p, rinv, hi, t == 0 ? 48 : 0, qp - kv0, pw);
            else sb_step<2, false>(p, rinv, hi, 0, 64, pw);
            pv64(o, vb0 + slot, __builtin_bit_cast(bf16x8, pw[0]), __builtin_bit_cast(bf16x8, pw[1]), __builtin_bit_cast(bf16x8, pw[2]), __builtin_bit_cast(bf16x8, pw[3]));
        }
        slot += SLOTB; if (slot >= NSLOT * SLOTB) slot = 0;
    }
#undef SB_DMA_KV
    { LAS bf16* stg = (LAS bf16*)(shm + LDS_OST) + wid * 2048;
#pragma unroll
        for (int r = 0; r < 16; ++r) { const int orow = crow(r, hi);
#pragma unroll
            for (int d0 = 0; d0 < 2; ++d0) stg[orow * 64 + d0 * 32 + r32] = (bf16)f2bf(o[d0][r]); }
        asm volatile("s_waitcnt lgkmcnt(0)" ::: "memory");
#pragma unroll
        for (int i = 0; i < 4; ++i) { const int row = i * 8 + (lane >> 3), ch = lane & 7; const u32x4 v = *(const LAS u32x4*)(stg + row * 64 + ch * 8);
            const int pos = qlo + row - 48;
            if (pos >= 0) *(u32x4*)(MIX + (size_t)(rowbase + pos) * D + h * HD + ch * 8) = v; } }
    asm volatile("s_waitcnt lgkmcnt(0)\n\ts_barrier" ::: "memory");
}
__device__ __forceinline__ int attn_unit4_barriers(int qbase) { return ((qbase + 127) >> 6) + 2; }

__device__ __forceinline__ void attn_unit_pipe4(LAS unsigned char* shm, int b, int h, int qbase, const bf16* Q, const bf16* K, const bf16* V, bf16* MIX, float biasl2) {
    const int tid = threadIdx.x, lane = tid & 63, r32 = lane & 31, hi = lane >> 5; const int wid = __builtin_amdgcn_readfirstlane(tid >> 6);
    const long rowbase = (long)b * TP;
    const int qlo = qbase + 32 * wid, qp = qlo + r32;
    const int qpos = (qp - 48) < 0 ? 0 : (qp - 48);
    const bf16* Qrow = Q + (rowbase + qpos) * KP + h * HD;
    const bf16* Kh = K + rowbase * KP + h * HD; const bf16* Vh = V + rowbase * KP + h * HD;
    const unsigned lds0 = (unsigned)(uintptr_t)shm;
    constexpr int K4 = 0, V4 = 4 * SLOTK;
    const unsigned kdst = lds0 + K4 + wid * 2 * KPIECE, vdst = lds0 + V4 + wid * 2048;
    const int t0 = (qbase + 127) >> 6;
    const float Bf = __builtin_amdgcn_exp2f(biasl2);
    const int ga = (2 * wid) & 3;
    const int kk = lane >> 3, ksl_ = lane & 7;
    const unsigned koff = (unsigned)(kk * 1024 + ((ksl_ ^ kk) * 16));
    const int kra = 16 * wid + kk - 48, krb = kra + 8;
    const unsigned koffA0 = (unsigned)((kra < 0 ? 0 : kra) * 1024 + ((ksl_ ^ kk) * 16)), koffB0 = (unsigned)((krb < 0 ? 0 : krb) * 1024 + ((ksl_ ^ kk) * 16));
    const unsigned vcol = (unsigned)(((wid >> 1) * 32 + (lane & 3) * 8) * 2);
    const unsigned voff = (unsigned)((16 * ga + (lane >> 2)) * 1024) + vcol;
    const int vra = 16 * ga + (lane >> 2) - 48, vrb = vra + 16;
    const unsigned voffA0 = (unsigned)((vra < 0 ? 0 : vra) * 1024) + vcol, voffB0 = (unsigned)((vrb < 0 ? 0 : vrb) * 1024) + vcol;
    const char* Kb = (const char*)Kh; const char* Vb = (const char*)Vh;
#define SB_DMA_K(j) do { const int t_ = t0 - (j); const unsigned d_ = (unsigned)__builtin_amdgcn_readfirstlane(kdst + ((j) & 3) * SLOTK); \
        if (t_ > 0) { const char* b_ = Kb + (size_t)(t_ * 64 - 48 + 16 * wid) * 1024; glds2_g<KPIECE>(b_, b_ + 8 * 1024, koff, koff, d_); } else glds2_g<KPIECE>(Kb, Kb, koffA0, koffB0, d_); } while (0)
#define SB_DMA_V(j) do { const int t_ = t0 - (j); const unsigned d_ = (unsigned)__builtin_amdgcn_readfirstlane(vdst + ((j) & 3) * SLOTB); \
        if (t_ > 0) { const char* b_ = Vb + (size_t)(t_ * 64 - 48) * 1024; glds2_g<1024>(b_, b_ + 16384, voff, voff, d_); } else glds2_g<1024>(Vb, Vb, voffA0, voffB0, d_); } while (0)
    AttSt st;
#pragma unroll
    for (int d0 = 0; d0 < 4; ++d0) st.qr[d0] = *(const bf16x8*)(Qrow + d0 * 16 + hi * 8);
    st.o[0] = f32x16{}; st.o[1] = f32x16{}; st.rinv = 1.f;
#pragma unroll
    for (int i = 0; i < 4; ++i) st.pw[i] = (u32x4){0u, 0u, 0u, 0u};
    const lds_ptr kp0 = (lds_ptr)shm + K4;
    int kqo[4];
#pragma unroll
    for (int d0 = 0; d0 < 4; ++d0) kqo[d0] = (r32 >> 3) * KPIECE + (r32 & 7) * 128 + (((2 * d0 + hi) ^ (r32 & 7)) * 16);
    const lds_ptr vp0 = (lds_ptr)shm + V4 + ((lane >> 4) & 1) * 32 + (lane & 3) * 8 + (4 * hi + ((lane & 15) >> 2)) * 64;
    SB_WAIT_BAR(0);
    f32x16 sA0, sA1, sB0, sB1;
    { const f32x16 z = f32x16{};
#pragma unroll
      for (int d0 = 0; d0 < 4; ++d0) { const bf16x8 b0 = *(const LAS bf16x8*)(kp0 + kqo[d0]), b1 = *(const LAS bf16x8*)(kp0 + kqo[d0] + 4 * KPIECE);
          sA0 = __builtin_amdgcn_mfma_f32_32x32x16_bf16(b0, st.qr[d0], d0 == 0 ? z : sA0, 0, 0, 0); sA1 = __builtin_amdgcn_mfma_f32_32x32x16_bf16(b1, st.qr[d0], d0 == 0 ? z : sA1, 0, 0, 0); } }
#define SB_ISSUE_AFTER(s) do { if ((s) + 3 <= t0) SB_DMA_K((s) + 3); if ((s) + 4 <= t0) SB_DMA_K((s) + 4); if ((s) + 1 <= t0) SB_DMA_V((s) + 1); if ((s) + 2 <= t0) SB_DMA_V((s) + 2); } while (0)
#define SB_STEP_HEAD(s) do { SB_WAIT_BAR(0); } while (0)
    asm volatile("s_waitcnt lgkmcnt(0)\n\ts_barrier" ::: "memory");
    att_step<true, true, false>(sA0, sA1, sB0, sB1, st, Bf, kp0 + 1 * SLOTK, kqo, vp0, hi, 0, qp - 64 * t0);
    att_step<true, true, true>(sB0, sB1, sA0, sA1, st, Bf, kp0 + 2 * SLOTK, kqo, vp0 + 0 * SLOTB, hi, 0, qp - 64 * (t0 - 1));
    int ksl = 3, vsl = 1;
    for (int s = 2; s < t0; s += 2) {
        SB_STEP_HEAD(s);
        att_step<false, true, true>(sA0, sA1, sB0, sB1, st, Bf, kp0 + ksl * SLOTK, kqo, vp0 + vsl * SLOTB, hi, 0, 64);
        ksl = (ksl + 1) & 3; vsl = (vsl + 1) & 3;
        att_step<false, true, true>(sB0, sB1, sA0, sA1, st, Bf, kp0 + ksl * SLOTK, kqo, vp0 + vsl * SLOTB, hi, 0, 64);
        ksl = (ksl + 1) & 3; vsl = (vsl + 1) & 3;
    }
    SB_STEP_HEAD(t0); att_step<true, false, true>(sA0, sA1, sB0, sB1, st, Bf, kp0, kqo, vp0 + vsl * SLOTB, hi, 48, qp);
    { const int vb = (int)(lds0 + V4) + ((lane >> 4) & 1) * 32 + (lane & 3) * 8 + (4 * hi + ((lane & 15) >> 2)) * 64 + (t0 & 3) * SLOTB;
      pv64(st.o, vb, __builtin_bit_cast(bf16x8, st.pw[0]), __builtin_bit_cast(bf16x8, st.pw[1]), __builtin_bit_cast(bf16x8, st.pw[2]), __builtin_bit_cast(bf16x8, st.pw[3])); }
#undef SB_ISSUE_AFTER
#undef SB_DMA_K
#undef SB_DMA_V
#undef SB_STEP_HEAD
    { int le = lane; asm volatile("" : "+v"(le));
      const int r32 = le & 31, hi = le >> 5, lane = le;
      LAS bf16* stg = (LAS bf16*)(shm + K4) + wid * 2048;
#pragma unroll
        for (int r = 0; r < 16; ++r) { const int orow = crow(r, hi);
#pragma unroll
            for (int d0 = 0; d0 < 2; ++d0) stg[orow * 64 + d0 * 32 + r32] = (bf16)f2bf(st.o[d0][r]); }
        asm volatile("s_waitcnt lgkmcnt(0)" ::: "memory");
#pragma unroll
        for (int i = 0; i < 4; ++i) { const int row = i * 8 + (lane >> 3), ch = lane & 7; const u32x4 v = *(const LAS u32x4*)(stg + row * 64 + ch * 8);
            const int pos = qlo + row - 48;
            if (pos >= 0) *(u32x4*)(MIX + (size_t)(rowbase + pos) * D + h * HD + ch * 8) = v; } }
    asm volatile("s_waitcnt lgkmcnt(0)\n\ts_barrier" ::: "memory");
}

__device__ __forceinline__ int attn_unit_pipe4_barriers(int qbase) { return (((qbase + 127) >> 6) >> 1) + 3; }

__device__ __forceinline__ int att_qbase(int ui) { const int k = ui >> 8, v = ui & 15; return ui >= 1024 ? -64 : 64 + 128 * (k == 0 ? v : k == 1 ? 31 - v : k == 2 ? 32 + v : 63 - v); }
struct AttLoader {
    unsigned koff, koffA0, koffB0, voff, voffA0, voffB0, kdst, vdst; int wid, G, ui, t0, i, last; const bf16* K; const bf16* V; const char* Kb; const char* Vb;
    __device__ __forceinline__ void dma_k(int j) const { const int t_ = t0 - j; const unsigned d_ = (unsigned)__builtin_amdgcn_readfirstlane(kdst + (j & 3) * SLOTK);
        if (t_ > 0) { const char* b_ = Kb + (size_t)(t_ * 64 - 48 + 16 * wid) * 1024; glds2_g<KPIECE>(b_, b_ + 8 * 1024, koff, koff, d_); } else glds2_g<KPIECE>(Kb, Kb, koffA0, koffB0, d_); }
    __device__ __forceinline__ void dma_v(int j) const { const int t_ = t0 - j; const unsigned d_ = (unsigned)__builtin_amdgcn_readfirstlane(vdst + (j & 3) * SLOTB);
        if (t_ > 0) { const char* b_ = Vb + (size_t)(t_ * 64 - 48) * 1024; glds2_g<1024>(b_, b_ + 16384, voff, voff, d_); } else glds2_g<1024>(Vb, Vb, voffA0, voffB0, d_); }
    __device__ __forceinline__ void unit() {
        if (ui >= 1024) { i = -1; return; }
        const int bh = (ui & 255) >> 4, b = bh >> 3, h = bh & 7; const long rowbase = (long)b * TP;
        t0 = (att_qbase(ui) + 127) >> 6; last = (t0 >> 1) + 2; i = 0;
        Kb = (const char*)(K + rowbase * KP + h * HD); Vb = (const char*)(V + rowbase * KP + h * HD);
        dma_k(0); dma_k(1); dma_k(2); dma_v(0);
    }
    __device__ __forceinline__ void init(LAS unsigned char* shm, int wid_, int lane, const bf16* K_, const bf16* V_, int vcu, int G_) {
        wid = wid_; G = G_; K = K_; V = V_; ui = vcu;
        const unsigned lds0 = (unsigned)(uintptr_t)shm;
        kdst = lds0 + wid * 2 * KPIECE; vdst = lds0 + 4 * SLOTK + wid * 2048;
        const int ga = (2 * wid) & 3, kk = lane >> 3, ksl_ = lane & 7;
        koff = (unsigned)(kk * 1024 + ((ksl_ ^ kk) * 16));
        const int kra = 16 * wid + kk - 48, krb = kra + 8;
        koffA0 = (unsigned)((kra < 0 ? 0 : kra) * 1024 + ((ksl_ ^ kk) * 16)); koffB0 = (unsigned)((krb < 0 ? 0 : krb) * 1024 + ((ksl_ ^ kk) * 16));
        const unsigned vcol = (unsigned)(((wid >> 1) * 32 + (lane & 3) * 8) * 2);
        voff = (unsigned)((16 * ga + (lane >> 2)) * 1024) + vcol;
        const int vra = 16 * ga + (lane >> 2) - 48, vrb = vra + 16;
        voffA0 = (unsigned)((vra < 0 ? 0 : vra) * 1024) + vcol; voffB0 = (unsigned)((vrb < 0 ? 0 : vrb) * 1024) + vcol;
        unit();
    }
    __device__ __forceinline__ void tick() {
        if (i < 0) return;
        if (i == last) { ui += G; unit(); return; }
        if (i >= 1) { const int s = 2 * (i - 1);
            if (s + 3 <= t0) dma_k(s + 3); if (s + 4 <= t0) dma_k(s + 4); if (s + 1 <= t0) dma_v(s + 1); if (s + 2 <= t0) dma_v(s + 2); }
        ++i;
    }
};

__device__ __forceinline__ void decode_item(LAS unsigned char* wl, int bd, int h, int s, const bf16* Q, const float* ck, const float* cv, const int* ptab,
                                            const float* kn, const float* vn, float biasl2, float* opart, float* rpart, int& nb, const int natt, const int lat, AttLoader& ld) {
    int lane = threadIdx.x & 63; asm volatile("" : "+v"(lane));
    const int r32 = lane & 31, hi = lane >> 5;
    bf16x8 qr[4];
    { const bf16* Qrow = Q + (size_t)(MP + bd * 8 + (r32 & 7)) * KP + h * HD;
#pragma unroll
      for (int d0 = 0; d0 < 4; ++d0) { bf16x8 v = *(const bf16x8*)(Qrow + d0 * 16 + hi * 8); if (r32 >= 8) v = (bf16x8){0, 0, 0, 0, 0, 0, 0, 0}; qr[d0] = v; } }
    f32x16 o[2]; o[0] = f32x16{}; o[1] = f32x16{}; float rinv = 1.f;
    f32x16 cinit;
#pragma unroll
    for (int r = 0; r < 16; ++r) cinit[r] = biasl2;
    const unsigned ldsw = (unsigned)__builtin_amdgcn_readfirstlane((unsigned)(uintptr_t)wl);
    const int ntile = s ? 33 : 32;
    const int lrow = lane >> 4, lch = lane & 15;
#define DEC_BAR(N) do { asm volatile("s_waitcnt vmcnt(" #N ")" ::: "memory"); if (nb < natt) { asm volatile("s_barrier" ::: "memory"); ++nb; ld.tick(); } } while (0)
#define DEC_SRC(j, KB_, VB_) do { if (s == 1 && (j) == 0) { const size_t off_ = (size_t)bd * 8 * 512 + h * HD; KB_ = kn + off_; VB_ = vn + off_; } \
        else { const int jj_ = s ? (j) - 1 : (j); const int pg_ = (s ? 15 : 7) - (jj_ >> 2); const int koff_ = (3 - (jj_ & 3)) * 32; const int page_ = ptab[bd * NPAGES + pg_]; \
               const size_t off_ = ((size_t)page_ * 128 + koff_) * 512 + h * HD; KB_ = ck + off_; VB_ = cv + off_; } } while (0)
    unsigned dvo[8];
#pragma unroll
    for (int i = 0; i < 8; ++i) dvo[i] = (unsigned)(i * 8192 + lrow * 2048 + ((lch ^ lrow ^ (4 * (i & 3))) * 16));
#define DEC_ISSUE(base_, ldsoff_) glds8_nt((base_), dvo, ldsw + (ldsoff_))
    { const float* kb_; const float* vb_; DEC_SRC(0, kb_, vb_);
      asm volatile("s_waitcnt lgkmcnt(0)" ::: "memory");
      DEC_ISSUE(kb_, 0); DEC_ISSUE(vb_, 8192); }
    DEC_BAR(16);
    for (int j = 0; j < ntile; ++j) {
        const bool isnew = (s == 1 && j == 0);
        const float* kn_ = nullptr; const float* vn_ = nullptr;
        if (j + 1 < ntile) DEC_SRC(j + 1, kn_, vn_);
        if (j == 0) DEC_BAR(0); else DEC_BAR(8);
        f32x16 p[1];
#pragma unroll
        for (int d0 = 0; d0 < 4; ++d0) { const int c = 4 * d0 + 2 * hi;
            const f32x4 a0 = *(const LAS f32x4*)(wl + r32 * 256 + ((c ^ (r32 & 15)) * 16)), a1 = *(const LAS f32x4*)(wl + r32 * 256 + (((c + 1) ^ (r32 & 15)) * 16));
            const u32x4 kw = (u32x4){cvtpk_s(a0.x, a0.y), cvtpk_s(a0.z, a0.w), cvtpk_s(a1.x, a1.y), cvtpk_s(a1.z, a1.w)};
            p[0] = __builtin_amdgcn_mfma_f32_32x32x16_bf16(__builtin_bit_cast(bf16x8, kw), qr[d0], d0 == 0 ? cinit : p[0], 0, 0, 0); }
        u32x4 pw[2];
        if (isnew) sb_step<1, true>(p, rinv, hi, 0, r32 < 8 ? r32 : 8, pw); else sb_step<1, false>(p, rinv, hi, 0, 32, pw);
        asm volatile("s_waitcnt lgkmcnt(0)" ::: "memory");
        if (j + 1 < ntile) DEC_ISSUE(kn_, 0);
        if (j + 1 < ntile) DEC_BAR(8); else DEC_BAR(0);
#pragma unroll
        for (int d0 = 0; d0 < 2; ++d0)
#pragma unroll
            for (int ks = 0; ks < 2; ++ks) { float vv[8]; const int dcol = 32 * d0 + r32;
#pragma unroll
                for (int i = 0; i < 8; ++i) { const int key = crow(i, hi) + 16 * ks; vv[i] = *(const LAS float*)(wl + 8192 + key * 256 + (((dcol >> 2) ^ (key & 15)) * 16) + (dcol & 3) * 4); }
                const u32x4 vw = (u32x4){cvtpk_s(vv[0], vv[1]), cvtpk_s(vv[2], vv[3]), cvtpk_s(vv[4], vv[5]), cvtpk_s(vv[6], vv[7])};
                o[d0] = __builtin_amdgcn_mfma_f32_32x32x16_bf16(__builtin_bit_cast(bf16x8, pw[ks]), __builtin_bit_cast(bf16x8, vw), o[d0], 0, 0, 0); }
        asm volatile("s_waitcnt lgkmcnt(0)" ::: "memory");
        if (j + 1 < ntile) DEC_ISSUE(vn_, 8192);
    }
#undef DEC_BAR
#undef DEC_SRC
#undef DEC_ISSUE
    const int item = (bd * 8 + h) * 2 + s;
#pragma unroll
    for (int d0 = 0; d0 < 2; ++d0)
#pragma unroll
        for (int r = 0; r < 4; ++r) opart[((size_t)item * 8 + r + 4 * hi) * 64 + d0 * 32 + r32] = o[d0][r];
    if (lane < 8) rpart[item * 8 + lane] = rinv;
}
#undef SB_WAIT_BAR
}

constexpr int NTILE_B = 257, NT_PROMPT = 2 * NTILE_B, NT_ALL = NT_PROMPT + 32;
constexpr int LRU_WAVE_LDS = 4608 + 8192;
struct LruC {
    const bf16* XL; const bf16* GATE; bf16* MIX; float* ATOT; float* BTOT; unsigned* LB;
    const float *wga, *bga, *wgx, *bgx, *convw, *convb, *lam, *sh, *sconv;
    float *hp_out, *cp_out, *hs_out, *cs_out;
};
typedef float f32x2v __attribute__((ext_vector_type(2)));
__device__ __forceinline__ float one_minus_exp(float x) {
    const float ser = -x * (1.f + x * (0.5f + x * (0.16666667f + x * (0.041666668f + x * 0.0083333338f))));
    const float dir = 1.f - __expf(x);
    return x > -0.25f ? ser : dir;
}
template <int MODE>
__device__ __forceinline__ void lru_phase(LAS unsigned char* wl, int vcu, int G, int n, const LruC& P) {
    int lane_ = threadIdx.x & 63; asm volatile("" : "+v"(lane_));
    const int lane = lane_, r32 = lane & 31, hi = lane >> 5, ch = n * 64 + lane;
    LAS bf16* XA = (LAS bf16*)wl;
    LAS f32x2v* LAG = (LAS f32x2v*)(wl + 4608);
    bf16x8 Ba[2][4], Bx[2][4];
#pragma unroll
    for (int dh = 0; dh < 2; ++dh)
#pragma unroll
        for (int ks = 0; ks < 4; ++ks) {
            const GAS float* wq = (const GAS float*)(P.wga + ((n * 64 + 16 * ks + 8 * hi) * 64 + 32 * dh + r32));
            const GAS float* xq = (const GAS float*)(P.wgx + ((n * 64 + 16 * ks + 8 * hi) * 64 + 32 * dh + r32));
            sb::u32x4 a, x; a.x = pk2(wq[0], wq[64]); a.y = pk2(wq[128], wq[192]); a.z = pk2(wq[256], wq[320]); a.w = pk2(wq[384], wq[448]);
            x.x = pk2(xq[0], xq[64]); x.y = pk2(xq[128], xq[192]); x.z = pk2(xq[256], xq[320]); x.w = pk2(xq[384], xq[448]);
            Ba[dh][ks] = __builtin_bit_cast(bf16x8, a); Bx[dh][ks] = __builtin_bit_cast(bf16x8, x); }
    float bac[2], bxc[2], spc[2];
#pragma unroll
    for (int dh = 0; dh < 2; ++dh) { const int d = n * 64 + 32 * dh + r32; bac[dh] = P.bga[d]; bxc[dh] = P.bgx[d]; spc[dh] = 8.0f * log1pf(__expf(-P.lam[d])); }
    const float cw0 = P.convw[ch], cw1 = P.convw[512 + ch], cw2 = P.convw[1024 + ch], cw3 = P.convw[1536 + ch], cb = P.convb[ch];
    unsigned rx[36]; float rs[12];
#define LRU_PREF(tile_) do { const int tl_ = (tile_); const bool sp_ = tl_ >= NT_PROMPT; int r0_; \
        if (!sp_) { const int b_ = tl_ / NTILE_B, c_ = tl_ - b_ * NTILE_B; r0_ = b_ * TP + (c_ == 0 ? 0 : 16 + 32 * (c_ - 1)); } else r0_ = MP + (tl_ - NT_PROMPT) * 32; \
        _Pragma("unroll") for (int t = 0; t < 36; ++t) { const int q_ = r0_ + t - 3 < 0 ? 0 : r0_ + t - 3; rx[t] = (unsigned)P.XL[(size_t)q_ * 512 + ch]; } \
        _Pragma("unroll") for (int q = 0; q < 4; ++q) { const int bd_ = sp_ ? ((r0_ - MP) >> 3) + q : q; _Pragma("unroll") for (int j = 0; j < 3; ++j) rs[3 * q + j] = P.sconv[(bd_ * 3 + j) * 512 + ch]; } } while (0)
    if (vcu < NT_ALL) LRU_PREF(vcu);
    for (int tile = vcu; tile < NT_ALL; tile += G) {
        const bool samp = tile >= NT_PROMPT;
        int row0, nv, b = 0, c = 0;
        if (!samp) { b = tile / NTILE_B; c = tile - b * NTILE_B; nv = c == 0 ? 16 : 32; row0 = b * TP + (c == 0 ? 0 : 16 + 32 * (c - 1)); }
        else { row0 = MP + (tile - NT_PROMPT) * 32; nv = 32; }
        unsigned xr[18];
        const bool first = samp || c == 0;
#pragma unroll
        for (int t = 0; t < 36; t += 2) { const int r0 = t - 3, r1 = t - 2;
            unsigned lo = rx[t], hi16 = rx[t + 1];
            lo = (r0 < nv && (!first || r0 >= 0)) ? lo : 0u; hi16 = (t + 1 < 35 && r1 < nv && (!first || r1 >= 0)) ? hi16 : 0u;
            xr[t >> 1] = lo | (hi16 << 16); }
        unsigned gr[16];
        if (MODE >= 1) {
#pragma unroll
            for (int t = 0; t < 32; t += 2) { unsigned lo = (unsigned)P.GATE[(size_t)(row0 + t) * 512 + ch], hi16 = (unsigned)P.GATE[(size_t)(row0 + t + 1) * 512 + ch];
                lo = (t < nv) ? lo : 0u; hi16 = (t + 1 < nv) ? hi16 : 0u; gr[t >> 1] = lo | (hi16 << 16); }
        }
#define LRU_XR(t) __builtin_bit_cast(float, ((t) & 1) ? (xr[(t) >> 1] & 0xffff0000u) : (xr[(t) >> 1] << 16))
#define LRU_GR(t) __builtin_bit_cast(float, ((t) & 1) ? (gr[(t) >> 1] & 0xffff0000u) : (gr[(t) >> 1] << 16))
        float scv[12], shv[4];
        {
#pragma unroll
            for (int q = 0; q < 4; ++q) { const int bd = samp ? ((row0 - MP) >> 3) + q : q;
#pragma unroll
                for (int j = 0; j < 3; ++j) scv[3 * q + j] = rs[3 * q + j];
                shv[q] = (MODE >= 1) ? P.sh[bd * 512 + ch] : 0.f; }
        }
        if (tile + G < NT_ALL) LRU_PREF(tile + G);
        float hst = 0.f, A = 1.f;
        if (MODE == 1 && !samp && c > 0) {
            const int seg = lane >> 4, q = lane & 15, cs = (c + 3) >> 2, lo = seg * cs, hi_ = (lo + cs) < c ? (lo + cs) : c;
            f32x4 A4 = (f32x4){1.f, 1.f, 1.f, 1.f}, B4 = (f32x4){0.f, 0.f, 0.f, 0.f};
            const float* ap = P.ATOT + (size_t)(b * NTILE_B) * 512 + n * 64 + 4 * q; const float* bp = P.BTOT + (size_t)(b * NTILE_B) * 512 + n * 64 + 4 * q;
#pragma unroll 8
            for (int cc = lo; cc < hi_; ++cc) { const f32x4 av = *(const f32x4*)(ap + (size_t)cc * 512), bv = *(const f32x4*)(bp + (size_t)cc * 512); B4 = av * B4 + bv; A4 = av * A4; }
#pragma unroll
            for (int j = 0; j < 4; ++j) LAG[seg * 64 + 4 * q + j] = (f32x2v){A4[j], B4[j]};
            asm volatile("s_waitcnt lgkmcnt(0)" ::: "memory");
#pragma unroll
            for (int sg = 0; sg < 4; ++sg) { const f32x2v ab = LAG[sg * 64 + lane]; hst = ab.x * hst + ab.y; }
            asm volatile("s_waitcnt lgkmcnt(0)" ::: "memory");
        }
        float x0 = LRU_XR(0), x1 = LRU_XR(1), x2 = LRU_XR(2);
#pragma unroll
        for (int t = 0; t < 32; ++t) {
            if ((t & 7) == 0) { x0 = samp ? scv[3 * (t >> 3)] : x0; x1 = samp ? scv[3 * (t >> 3) + 1] : x1; x2 = samp ? scv[3 * (t >> 3) + 2] : x2; }
            const float x3 = LRU_XR(t + 3);
            const float xc = cb + x0 * cw0 + x1 * cw1 + x2 * cw2 + x3 * cw3;
            XA[t * 72 + lane] = (bf16)f2bf(xc);
            x0 = x1; x1 = x2; x2 = x3;
        }
        if (MODE == 0) {
            if (samp) {
#pragma unroll
                for (int q = 0; q < 4; ++q)
#pragma unroll
                    for (int j = 0; j < 3; ++j) P.cs_out[((((row0 - MP) >> 3) + q) * 3 + j) * 512 + ch] = LRU_XR(3 + 8 * q + 5 + j);
            } else if (c == NTILE_B - 1) {
#pragma unroll
                for (int j = 0; j < 3; ++j) P.cp_out[(b * 3 + j) * 512 + ch] = LRU_XR(3 + 29 + j);
            }
        }
        asm volatile("s_waitcnt lgkmcnt(0)" ::: "memory");
        f32x16 ga[2], gx[2];
        {
            bf16x8 Af[4];
#pragma unroll
            for (int ks = 0; ks < 4; ++ks) Af[ks] = *(const LAS bf16x8*)((const LAS char*)XA + r32 * 144 + (16 * ks + 8 * hi) * 2);
#pragma unroll
            for (int dh = 0; dh < 2; ++dh) {
                f32x16 za = f32x16{}, zx = f32x16{};
#pragma unroll
                for (int ks = 0; ks < 4; ++ks) { za = __builtin_amdgcn_mfma_f32_32x32x16_bf16(Af[ks], Ba[dh][ks], za, 0, 0, 0); zx = __builtin_amdgcn_mfma_f32_32x32x16_bf16(Af[ks], Bx[dh][ks], zx, 0, 0, 0); }
                ga[dh] = za; gx[dh] = zx;
            }
        }
        asm volatile("" ::: "memory");
        float hsv[4] = {0.f, 0.f, 0.f, 0.f};
#pragma unroll
        for (int half = 0; half < 2; ++half) {
#pragma unroll
            for (int dh = 0; dh < 2; ++dh)
#pragma unroll
                for (int rr = 0; rr < 8; ++rr) { const int r = 8 * half + rr;
                    const float rg = sigmoidf_(ga[dh][r] + bac[dh]), ig = sigmoidf_(gx[dh][r] + bxc[dh]);
                    const float la = -spc[dh] * rg; const float g2 = __builtin_amdgcn_sqrtf(one_minus_exp(2.f * la)) * ig;
                    LAG[sb::crow(rr, hi) * 64 + 32 * dh + r32] = (f32x2v){la, g2}; }
            asm volatile("s_waitcnt lgkmcnt(0)" ::: "memory");
#pragma unroll
            for (int t16 = 0; t16 < 16; ++t16) { const int t = 16 * half + t16;
                const f32x2v ag = LAG[t16 * 64 + lane];
                if (t < nv) {
                    if (MODE >= 1 && (t & 7) == 0) hst = samp ? shv[t >> 3] : hst;
                    const unsigned lab = pk2(ag.x, ag.y * bf2f(XA[t * 72 + lane]));
                    const float ar = __expf(__builtin_bit_cast(float, lab << 16)), br = __builtin_bit_cast(float, lab & 0xffff0000u);
                    if (MODE == 0) P.LB[(size_t)(row0 + t) * 512 + ch] = lab;
                    hst = ar * hst + br; A *= ar;
                    if (MODE >= 1) {
                        const size_t row = (size_t)(row0 + t);
                        const float g = LRU_GR(t); P.MIX[row * D + 512 + ch] = (bf16)f2bf(hst * gelu_tanh(g));
                        if ((t & 7) == 7) hsv[t >> 3] = hst;
                    }
                }
            }
            asm volatile("s_waitcnt lgkmcnt(0)" ::: "memory");
        }
        if (MODE == 0 && !samp) { P.ATOT[(b * NTILE_B + c) * 512 + ch] = A; P.BTOT[(b * NTILE_B + c) * 512 + ch] = hst; }
        if (MODE >= 1) {
            if (samp) {
#pragma unroll
                for (int q = 0; q < 4; ++q) P.hs_out[(((row0 - MP) >> 3) + q) * 512 + ch] = hsv[q];
            } else if (c == NTILE_B - 1) P.hp_out[b * 512 + ch] = hsv[3];
        }
    }
}
__device__ __forceinline__ void lru_rescan(LAS unsigned char* wl, int vcu, int G, int n, const LruC& P) {
    int lane_ = threadIdx.x & 63; asm volatile("" : "+v"(lane_));
    const int lane = lane_, ch = n * 64 + lane;
    LAS f32x2v* LAG = (LAS f32x2v*)(wl + 4608);
    for (int it = vcu; it < NT_ALL; it += G) {
        const int tile = it < 256 ? it + 1 : it < 512 ? 769 - it : it == 512 ? 0 : it == 513 ? NTILE_B : NT_PROMPT + (it - 514);
        const bool samp = tile >= NT_PROMPT;
        int row0, nv, b = 0, c = 0;
        if (!samp) { b = tile / NTILE_B; c = tile - b * NTILE_B; nv = c == 0 ? 16 : 32; row0 = b * TP + (c == 0 ? 0 : 16 + 32 * (c - 1)); }
        else { row0 = MP + (tile - NT_PROMPT) * 32; nv = 32; }
        unsigned lb[32]; unsigned gr[16]; float shv[4];
#pragma unroll
        for (int t = 0; t < 32; ++t) lb[t] = P.LB[(size_t)(row0 + t) * 512 + ch];
#pragma unroll
        for (int t = 0; t < 32; t += 2) gr[t >> 1] = (unsigned)P.GATE[(size_t)(row0 + t) * 512 + ch] | ((unsigned)P.GATE[(size_t)(row0 + t + 1) * 512 + ch] << 16);
#pragma unroll
        for (int q = 0; q < 4; ++q) shv[q] = P.sh[(samp ? ((row0 - MP) >> 3) + q : q) * 512 + ch];
        float hst = 0.f;
        if (!samp && c > 0) {
            const int seg = lane >> 4, q = lane & 15, cs = (c + 3) >> 2, lo = seg * cs, hi_ = (lo + cs) < c ? (lo + cs) : c;
            f32x4 A4 = (f32x4){1.f, 1.f, 1.f, 1.f}, B4 = (f32x4){0.f, 0.f, 0.f, 0.f};
            const float* ap = P.ATOT + (size_t)(b * NTILE_B) * 512 + n * 64 + 4 * q; const float* bp = P.BTOT + (size_t)(b * NTILE_B) * 512 + n * 64 + 4 * q;
#pragma unroll 16
            for (int cc = lo; cc < hi_; ++cc) { const f32x4 av = *(const f32x4*)(ap + (size_t)cc * 512), bv = *(const f32x4*)(bp + (size_t)cc * 512); B4 = av * B4 + bv; A4 = av * A4; }
#pragma unroll
            for (int j = 0; j < 4; ++j) LAG[seg * 64 + 4 * q + j] = (f32x2v){A4[j], B4[j]};
            asm volatile("s_waitcnt lgkmcnt(0)" ::: "memory");
#pragma unroll
            for (int sg = 0; sg < 4; ++sg) { const f32x2v ab = LAG[sg * 64 + lane]; hst = ab.x * hst + ab.y; }
            asm volatile("s_waitcnt lgkmcnt(0)" ::: "memory");
        }
        float hsv[4] = {0.f, 0.f, 0.f, 0.f};
#pragma unroll
        for (int t = 0; t < 32; ++t) {
            if ((t & 7) == 0) hst = samp ? shv[t >> 3] : hst;
            const float a = __expf(__builtin_bit_cast(float, lb[t] << 16)), bb = __builtin_bit_cast(float, lb[t] & 0xffff0000u);
            const float hn = a * hst + bb; hst = (t < nv) ? hn : hst;
            const float g = __builtin_bit_cast(float, (t & 1) ? (gr[t >> 1] & 0xffff0000u) : (gr[t >> 1] << 16));
            P.MIX[(size_t)((t < nv) ? row0 + t : MREAL + t) * D + 512 + ch] = (bf16)f2bf(hst * gelu_tanh(g));
            if ((t & 7) == 7) hsv[t >> 3] = hst;
        }
        if (samp) {
#pragma unroll
            for (int q = 0; q < 4; ++q) P.hs_out[(((row0 - MP) >> 3) + q) * 512 + ch] = hsv[q];
        } else if (c == NTILE_B - 1) P.hp_out[b * 512 + ch] = hsv[3];
    }
}
__device__ __forceinline__ void dec_combine(int vcu, int G, bf16* MIX, const float* opart, const float* rpart) {
    const int ch = threadIdx.x, hh = ch >> 6, d = ch & 63;
#pragma unroll 4
    for (int srow = vcu; srow < MSAMP; srow += G) { const int bd = srow >> 3, q = srow & 7;
        const int i0 = (bd * 8 + hh) * 2, i1 = i0 + 1;
        const float v = opart[((size_t)i1 * 8 + q) * 64 + d] + rpart[i1 * 8 + q] * opart[((size_t)i0 * 8 + q) * 64 + d];
        MIX[(size_t)(MP + srow) * D + ch] = (bf16)f2bf(v); }
}

#define IDLE_CU_COPY(S_, W_, K_, N_, WT_) do { const int nbusy_ = (S_).nwg % G; if (bx >= nbusy_) { __syncthreads();     \
        LAS float* scr_ = (LAS float*)(L + wave * 16384); int ln_ = threadIdx.x & 63; asm volatile("" : "+v"(ln_)); const int nidle_ = (G - nbusy_) * NWAVES; \
        for (int it_ = (bx - nbusy_) * NWAVES + wave; it_ < ((K_) / 64) * ((N_) / 32); it_ += nidle_) p0_transpose_item((W_), (K_), (N_), (WT_), 0, scr_, it_, ln_); } } while (0)
#define IDLE_CU_COPY_N(NBUSY_, W_, K_, N_, WT_) do { const int nbusy_ = (NBUSY_); if (bx >= nbusy_) { __syncthreads(); \
        LAS float* scr_ = (LAS float*)(L + wave * 16384); int ln_ = threadIdx.x & 63; asm volatile("" : "+v"(ln_)); const int nidle_ = (G - nbusy_) * NWAVES; \
        for (int it_ = (bx - nbusy_) * NWAVES + wave; it_ < ((K_) / 64) * ((N_) / 32); it_ += nidle_) p0_transpose_item((W_), (K_), (N_), (WT_), 0, scr_, it_, ln_); } } while (0)
#ifndef DEC_LAT
#define DEC_LAT 3
#endif
#ifndef PROBE_ATT_REPS
#define PROBE_ATT_REPS 1
#endif
#ifndef PROBE_LRU_REPS
#define PROBE_LRU_REPS 1
#endif
#ifndef PROBE_FIX_REPS
#define PROBE_FIX_REPS 1
#endif
#ifndef PROBE_DEC_REPS
#define PROBE_DEC_REPS 1
#endif
struct Args { const void* in[24]; float* out; unsigned char* ws; };
__global__ void __launch_bounds__(NWAVES * 64, 2) hymba_fwd(Args args) {
    extern __shared__ __attribute__((aligned(16))) unsigned char lds[];
    LAS unsigned char* L = (LAS unsigned char*)lds;
    volatile LAS unsigned* MISC = (volatile LAS unsigned*)(L + MISC_OFF);
    const int tid = threadIdx.x, lane = tid & 63, wave = __builtin_amdgcn_readfirstlane(tid >> 6);
    const int G = gridDim.x; const int bx = blockIdx.x; const int vcu = (G % 8 == 0) ? (bx % 8) * (G / 8) + bx / 8 : bx;
    unsigned char* ws = args.ws;
    gu32* ctl = (gu32*)(ws + WS_CTL);
    const float* x_prompt = (const float*)args.in[0]; const float* x_sample = (const float*)args.in[1];
    const float* cache_k = (const float*)args.in[2]; const float* cache_v = (const float*)args.in[3];
    const float* state_h = (const float*)args.in[4]; const float* state_conv = (const float*)args.in[5];
    const int* page_table = (const int*)args.in[6]; const float* meta = (const float*)args.in[7];
    const float* g_mix_pre = (const float*)args.in[8]; const float* g_mix_post = (const float*)args.in[9];
    const float* g_mlp_pre = (const float*)args.in[10]; const float* g_mlp_post = (const float*)args.in[11];
    const float* w_in = (const float*)args.in[12]; const float* sb_bias = (const float*)args.in[13];
    const float* conv_w = (const float*)args.in[14]; const float* conv_b = (const float*)args.in[15];
    const float* w_gate_a = (const float*)args.in[16]; const float* b_gate_a = (const float*)args.in[17];
    const float* w_gate_x = (const float*)args.in[18]; const float* b_gate_x = (const float*)args.in[19];
    const float* lru_lambda = (const float*)args.in[20]; const float* w_out = (const float*)args.in[21];
    const float* w_up = (const float*)args.in[22]; const float* w_down = (const float*)args.in[23];
    float* out = args.out;
    bf16* WT_IN = (bf16*)(ws + WS_WIN); bf16* WT_OUT = (bf16*)(ws + WS_WOUT); bf16* WT_UP = (bf16*)(ws + WS_WUP); bf16* WT_DN = (bf16*)(ws + WS_WDN);
    bf16* XN = (bf16*)(ws + WS_XN); bf16* QB = (bf16*)(ws + WS_Q); bf16* KB = (bf16*)(ws + WS_K); bf16* VB = (bf16*)(ws + WS_V); bf16* XLB = (bf16*)(ws + WS_XL); bf16* GATEB = (bf16*)(ws + WS_GATE);
    bf16* MIX = (bf16*)(ws + WS_MIX); float* MIXED = (float*)(ws + WS_MIXED); float* X1 = (float*)(ws + WS_X1); bf16* XN2 = (bf16*)(ws + WS_XN2); bf16* HB = (bf16*)(ws + WS_H); float* DOWN = (float*)(ws + WS_DOWN);
    float* RS0 = (float*)(ws + WS_RS0); float* RS2 = RS0 + MPAD;
    float* OPART = (float*)(ws + WS_OPART); float* RPART = (float*)(ws + WS_RPART);

    for (int u = tid; u < (LDS_BYTES - LDSCTL_OFF) / 4; u += NWAVES * 64) ((LAS unsigned*)(L + LDSCTL_OFF))[u] = 0u;
    __syncthreads();
    XcdBarrier bar = xcd_barrier_post((unsigned*)(ctl + CW_BAR), MISC + 8);
    const int gw = vcu * NWAVES + wave, NGW = G * NWAVES;

    {
        LAS float* scr = (LAS float*)(L + wave * 16384);
        constexpr int I_IN = (D / 64) * (NPROJ / 32), I_OUT = (D / 64) * (D / 32), I_UP = (D / 64) * (FF / 32), I_DN = (FF / 64) * (D / 32);
        for (int it = gw; it < I_IN; it += NGW) p0_transpose_item(w_in, D, NPROJ, WT_IN, 0, scr, it, lane);
        { int l0 = lane; asm volatile("" : "+v"(l0));
          const GAS f32x4* gq = (const GAS f32x4*)g_mix_pre + l0; f32x4 gg[4];
#pragma unroll
          for (int j = 0; j < 4; ++j) gg[j] = gq[64 * j];
          for (int mb = gw; mb < MPAD; mb += 3 * NGW) {
            f32x4 v[3][4];
#pragma unroll
            for (int r = 0; r < 3; ++r) { const int m = mb + r * NGW; const int mc = m < MREAL ? m : MREAL - 1;
                const GAS f32x4* xr = (const GAS f32x4*)xrow_ptr(mc, x_prompt, x_sample, meta) + l0;
#pragma unroll
                for (int j = 0; j < 4; ++j) v[r][j] = __builtin_nontemporal_load(xr + 64 * j); }
#pragma unroll
            for (int r = 0; r < 3; ++r) { const int m = mb + r * NGW;
                if (m < MREAL) {
                    float sq = 0.f;
#pragma unroll
                    for (int j = 0; j < 4; ++j) sq += dot4(v[r][j]);
                    const float sd = sqrtf(wave_sum(sq) * (1.f / D) + RMS_EPS), rstd = 1.0f / sd;
                    if (l0 == 0) RS0[m] = sd;
                    GAS unsigned long long* o8 = (GAS unsigned long long*)(XN + (size_t)m * D) + l0;
#pragma unroll
                    for (int j = 0; j < 4; ++j) o8[64 * j] = pack4(v[r][j] * rstd * gg[j]);
                } else if (m < MPAD) { GAS unsigned long long* a = (GAS unsigned long long*)(XN + (size_t)m * D) + l0; GAS unsigned long long* b2 = (GAS unsigned long long*)(MIX + (size_t)m * D) + l0; GAS unsigned long long* c2 = (GAS unsigned long long*)(XN2 + (size_t)m * D) + l0;
#pragma unroll
                    for (int j = 0; j < 4; ++j) { a[64 * j] = 0ull; b2[64 * j] = 0ull; c2[64 * j] = 0ull; } }
            }
          }
        }
    }
    xcd_arrive(bar);
    {   LAS float* scr = (LAS float*)(L + wave * 16384);
        int lane3 = threadIdx.x & 63; asm volatile("" : "+v"(lane3));
        for (int it = gw; it < (FF / 64) * (D / 32); it += NGW) p0_transpose_item(w_down, FF, D, WT_DN, 0, scr, it, lane3);
    }
    if (wave == 0) xcd_wait_wave(bar);
    __syncthreads();

    {
        pg8::Gemm g{XN, WT_IN, MPAD, NPROJ, D}; pg8::StaticOrder S; S.init(MPAD, NPROJ, D, G, bx);
        pg8::EpiProj E{QB, (size_t)WS_SPLIT / 2, QSCALE, out + O_KP, out + O_VP, out + O_KS, out + O_VS, MP, MREAL};
        pg8::gemm_phase<pg8::EpiProj, pg8::StaticOrder, true, true>(L, g, S, E);
    }
    xcd_arrive(bar);

    const LruC LP{XLB, GATEB, MIX, (float*)(ws + WS_ATOT), (float*)(ws + WS_BTOT), (unsigned*)(ws + WS_HLOC),
                  w_gate_a, b_gate_a, w_gate_x, b_gate_x, conv_w, conv_b, lru_lambda, state_h, state_conv, out + O_HP, out + O_CP, out + O_HS, out + O_CS};

    {
#define ATT_QBASE(ui) ((ui) >= 1024 ? -64 : 64 + 128 * ((((ui) >> 8) == 0) ? ((ui) & 15) : (((ui) >> 8) == 1) ? 31 - ((ui) & 15) : (((ui) >> 8) == 2) ? 32 + ((ui) & 15) : 63 - ((ui) & 15)))
        int natt = 0;
        const int meta_bh = (vcu >= G - 16) ? G - 1 - vcu : -1;
        for (int ui = vcu; ui < 1024; ui += G) natt += sb::attn_unit_pipe4_barriers(ATT_QBASE(ui));
        if (meta_bh >= 0) natt += sb::attn_unit4_barriers(-64);
        if (wave == 0) xcd_wait_wave(bar);
        __syncthreads();
        if (wave < 4) {
            for (int ui = vcu; ui < 1024; ui += G) {
                const int bh = (ui & 255) >> 4;
                sb::attn_unit_pipe4(L, bh >> 3, bh & 7, ATT_QBASE(ui), QB, KB, VB, MIX, sb_bias[bh & 7] * LOG2E);
            }
            if (meta_bh >= 0) sb::attn_unit4(L, meta_bh >> 3, meta_bh & 7, -64, QB, KB, VB, MIX, sb_bias[meta_bh & 7] * LOG2E);
        } else {
            int nb = 0; sb::AttLoader ld; ld.init(L, wave - 4, threadIdx.x & 63, KB, VB, vcu, G);
            for (int du = vcu; du < 2 * DEC_B; du += G)
                for (int hh = 0; hh < 2; ++hh) { const int h = (wave - 4) + 4 * hh;
                    sb::decode_item(L + (wave == 7 ? 147456 : 69632 + (wave - 4) * 16384), du >> 1, h, du & 1, QB, cache_k, cache_v, page_table, out + O_KS, out + O_VS, sb_bias[h] * LOG2E, OPART, RPART, nb, natt, DEC_LAT, ld); }
            while (nb < natt) { asm volatile("s_waitcnt vmcnt(0)\n\ts_barrier" ::: "memory"); ++nb; ld.tick(); }
        }
#undef ATT_QBASE
        __syncthreads();
        lru_phase<0>(L + wave * LRU_WAVE_LDS, vcu, G, wave, LP);
    }
    xcd_arrive(bar);
    {   LAS float* scr = (LAS float*)(L + wave * 16384);
        int lane3 = threadIdx.x & 63; asm volatile("" : "+v"(lane3));
        for (int it = NGW - 1 - gw; it < (D / 64) * (D / 32); it += NGW) p0_transpose_item(w_out, D, D, WT_OUT, 0, scr, it, lane3);
    }
    if (wave == 0) xcd_wait_wave(bar);
    __syncthreads();

    lru_rescan(L + wave * LRU_WAVE_LDS, vcu, G, wave, LP);
    dec_combine(vcu, G, MIX, OPART, RPART);
    xcd_arrive(bar);
    {   LAS float* scr = (LAS float*)(L + wave * 16384);
        int lane3 = threadIdx.x & 63; asm volatile("" : "+v"(lane3));
        for (int it = gw; it < (D / 64) * (FF / 32); it += NGW) p0_transpose_item(w_up, D, FF, WT_UP, 0, scr, it, lane3);
    }
    if (wave == 0) xcd_wait_wave(bar);
    __syncthreads();

    {
        pg8::Gemm g{MIX, WT_OUT, MPAD, D, D}; pg8::StaticOrder S; S.init(64 * 256, D, D, G, bx);
        pg8::EpiBf16P E{(pg8::bf16_t*)MIXED, D};
        pg8::gemm_phase<pg8::EpiBf16P, pg8::StaticOrder, true, true>(L, g, S, E);
        xcd_arrive(bar);
        if (bx < 40) {
            const int e = bx >> 1, sl = bx & 1;
            OneUnitOrder S1; S1.u0.pm = 64 + (e >> 2); S1.u0.pn = e & 3; S1.u0.nk = (D / 128) / 2; S1.u0.kb = sl * S1.u0.nk; S1.u0.part = 1 + bx;
            pg8::EpiBf16Slab E2{(pg8::bf16_t*)MIXED, D, (float*)(ws + WS_SLAB)};
            pg8::gemm_phase<pg8::EpiBf16Slab, OneUnitOrder, true, true>(L, g, S1, E2);
            cnt_arrive((unsigned*)(ctl + CW_CNTC));
        }
    }

    { int lane5 = threadIdx.x & 63; asm volatile("" : "+v"(lane5)); const int lane = lane5;
    f32x4 ig0[4], g1v[4], g2v[4];
#pragma unroll
    for (int j = 0; j < 4; ++j) { const f32x4 gp = ((const GAS f32x4*)g_mix_pre + lane)[64 * j]; ig0[j] = (f32x4){1.f / gp.x, 1.f / gp.y, 1.f / gp.z, 1.f / gp.w}; g1v[j] = ((const GAS f32x4*)g_mix_post + lane)[64 * j]; g2v[j] = ((const GAS f32x4*)g_mlp_pre + lane)[64 * j]; }
    unsigned long long nm[4], nx[4]; float nsd = 0.f;
#define P5_LOAD(mm) do { const GAS unsigned long long* mr_ = (const GAS unsigned long long*)((const bf16*)MIXED + (size_t)(mm) * D) + lane; const GAS unsigned long long* xr_ = (const GAS unsigned long long*)(XN + (size_t)(mm) * D) + lane; \
        _Pragma("unroll") for (int j = 0; j < 4; ++j) { nm[j] = __builtin_nontemporal_load(mr_ + 64 * j); nx[j] = __builtin_nontemporal_load(xr_ + 64 * j); } nsd = RS0[(mm)]; } while (0)
    for (int pass = 0; pass < 2; ++pass) {
    if (pass == 0 && bx < 40) continue;
    if (wave == 0) { if (pass == 0) xcd_wait_wave(bar); else { if (bx < 40) xcd_wait_wave(bar); cnt_wait_wave((unsigned*)(ctl + CW_CNTC), 40u, bar.bar); } }
    __syncthreads();
    const int r0 = pass == 0 ? (bx - 40) * NWAVES + wave : 64 * 256 + gw, rstep = pass == 0 ? (G - 40) * NWAVES : NGW, rend = pass == 0 ? 64 * 256 : MREAL;
    if (r0 < rend) P5_LOAD(r0);
    for (int m = r0; m < rend; m += rstep) {
        f32x4 v[4], xv[4]; float s = 0.f; const float sd0 = nsd;
#pragma unroll
        for (int j = 0; j < 4; ++j) { v[j] = unpack4(nm[j]); xv[j] = unpack4(nx[j]); }
        if (m + rstep < rend) P5_LOAD(m + rstep);
        if (pass == 1) {
#pragma unroll
            for (int j = 0; j < 4; ++j) { const int e = ((m >> 8) - 64) * 4 + j;
                const GAS unsigned long long* sp = (const GAS unsigned long long*)((const bf16*)(ws + WS_SLAB) + (size_t)(2 * e) * 65536 + (size_t)(m & 255) * 256) + lane;
                v[j] = unpack4(sp[0]) + unpack4(sp[16384]); }
        }
#pragma unroll
        for (int j = 0; j < 4; ++j) s += dot4(v[j]);
        const float rstd = 1.0f / sqrtf(wave_sum(s) * (1.f / D) + RMS_EPS);
        float s2 = 0.f;
#pragma unroll
        for (int j = 0; j < 4; ++j) { xv[j] = xv[j] * sd0 * ig0[j] + v[j] * rstd * g1v[j]; s2 += dot4(xv[j]); }
        const float sd2 = sqrtf(wave_sum(s2) * (1.f / D) + RMS_EPS), rstd2 = 1.0f / sd2;
        if (lane == 0) RS2[m] = sd2;
        GAS unsigned long long* o8 = (GAS unsigned long long*)(XN2 + (size_t)m * D) + lane;
#pragma unroll
        for (int j = 0; j < 4; ++j) o8[64 * j] = pack4(xv[j] * rstd2 * g2v[j]);
    }
    }
#undef P5_LOAD
    }
    xcd_arrive(bar);

    unsigned* cntB = (unsigned*)(ctl + CW_CNTB);
    int late_u = -1, early_rank = -1;
    { pg8::StaticOrder sd; sd.init(64 * 256, D, FF, G, bx); pg8::Unit ud; sd.next(0, ud);
      const int x = ud.pm >> 3, pl = ud.pm & 7, nl = x < 4 ? 3 : 2;
      if (pl < nl) late_u = (x < 4 ? 12 * x : 48 + 8 * (x - 4)) + pl * 4 + ud.pn;
      else early_rank = (x < 4 ? 20 * x : 80 + 24 * (x - 4)) + (pl - nl) * 4 + ud.pn; }
    if (wave == 0) xcd_wait_wave(bar);
    __syncthreads();
    {
        pg8::Gemm g{XN2, WT_UP, MPAD, FF, D}; pg8::StaticOrder S; S.init(64 * 256, FF, D, G, bx);
        pg8::EpiRelu2 E{HB, FF};
        pg8::gemm_phase<pg8::EpiRelu2, pg8::StaticOrder, true, true>(L, g, S, E);
        xcd_arrive(bar);
        if (late_u >= 0) {
            const int u = late_u;
            OneUnitOrder S1; S1.u0.pm = 64 + (u >> 4); S1.u0.pn = u & 15; S1.u0.kb = 0; S1.u0.nk = D / 128; S1.u0.part = 0;
            pg8::gemm_phase<pg8::EpiRelu2, OneUnitOrder, true, true>(L, g, S1, E);
            cnt_arrive(cntB);
        }
    }
    {
        pg8::Gemm g{HB, WT_DN, MPAD, D, FF}; DownOrder S; S.so.init(64 * 256, D, FF, G, bx); S.b = &bar; S.cntB = cntB;
        S.slice = (early_rank >= 0 && early_rank < 160) ? early_rank : -1;
        pg8::EpiBf16Slab E{(pg8::bf16_t*)DOWN, D, (float*)(ws + WS_SLAB)};
        pg8::gemm_phase<pg8::EpiBf16Slab, DownOrder, true, true>(L, g, S, E);
    }
    xcd_arrive(bar);

    { int lane8 = threadIdx.x & 63; asm volatile("" : "+v"(lane8)); const int lane = lane8;
    LAS unsigned char* tab = L;
    for (int t = tid; t < (MPAD / 256) * 4; t += NWAVES * 64) tab[t] = 0;
    __syncthreads();
    if (tid < 20) tab[(64 + (tid >> 2)) * 4 + (tid & 3)] = (unsigned char)(1 + tid);
    __syncthreads();
    const float* slab = (const float*)(ws + WS_SLAB); const int NS8 = 8;
    f32x4 ig2[4];
#pragma unroll
    for (int j = 0; j < 4; ++j) { const f32x4 gp = ((const GAS f32x4*)g_mlp_pre + lane)[64 * j]; ig2[j] = (f32x4){1.f / gp.x, 1.f / gp.y, 1.f / gp.z, 1.f / gp.w}; }
    f32x4 g1r[4];
#pragma unroll
    for (int j = 0; j < 4; ++j) g1r[j] = ((const GAS f32x4*)g_mlp_post + lane)[64 * j];
    if (wave == 0) xcd_wait_wave(bar);
    __syncthreads();
    unsigned long long nd[4], nx[4]; float nsd = 0.f;
#define P8_LOAD(mm) do { const GAS unsigned long long* dr_ = (const GAS unsigned long long*)((const bf16*)DOWN + (size_t)(mm) * D) + lane; const GAS unsigned long long* xr_ = (const GAS unsigned long long*)(XN2 + (size_t)(mm) * D) + lane; \
        _Pragma("unroll") for (int j = 0; j < 4; ++j) { nd[j] = __builtin_nontemporal_load(dr_ + 64 * j); nx[j] = __builtin_nontemporal_load(xr_ + 64 * j); } nsd = RS2[(mm)]; } while (0)
    if (gw < MREAL) P8_LOAD(gw);
    for (int m = gw; m < MREAL; m += NGW) {
        f32x4 v[4], x1v[4]; float s = 0.f; const float sd2 = nsd;
#pragma unroll
        for (int j = 0; j < 4; ++j) { v[j] = unpack4(nd[j]); x1v[j] = unpack4(nx[j]); }
        if (m + NGW < MREAL) P8_LOAD(m + NGW);
        float* dst = nullptr;
        if (m < MP) { const int b = m >= TP ? 1 : 0; const int t = m - b * TP; if (t >= NMETA) dst = out + O_YP + ((size_t)b * SEQ + (t - NMETA)) * D; }
        else dst = out + O_YS + (size_t)(m - MP) * D;
        if (dst == nullptr) continue;
#pragma unroll
        for (int j = 0; j < 4; ++j) {
            const int e1 = tab[(m >> 8) * 4 + j];
            if (e1 != 0) { f32x4 a4 = (f32x4){0.f, 0.f, 0.f, 0.f}; const GAS unsigned long long* sp = (const GAS unsigned long long*)((const bf16*)slab + (size_t)(e1 - 1) * NS8 * 65536 + (size_t)(m & 255) * 256) + lane;
                   for (int sl = 0; sl < NS8; ++sl) a4 = a4 + unpack4(sp[(size_t)sl * 16384]); v[j] = a4; }
            s += dot4(v[j]); }
        const float rstd = 1.0f / sqrtf(wave_sum(s) * (1.f / D) + RMS_EPS);
        GAS f32x4* o4 = (GAS f32x4*)dst + lane;
#pragma unroll
        for (int j = 0; j < 4; ++j) o4[64 * j] = x1v[j] * sd2 * ig2[j] + v[j] * rstd * g1r[j];
    }
#undef P8_LOAD
    }
}

extern "C" void kernel_launch(void* const* d_in, const int* in_sizes, int n_in, void* d_out, int out_size, void* d_ws, size_t ws_size, hipStream_t stream) {
    static int grid = 0;
    if (grid == 0) {
        if (n_in != 24 || out_size != (int)O_END || ws_size < WS_END) { fprintf(stderr, "kernel_launch: unexpected shapes: n_in %d out %d ws %zu\n", n_in, out_size, ws_size); grid = -1; return; }
        int dev = 0, cus = 0, per_cu = 0;
        if (hipGetDevice(&dev) != hipSuccess || hipDeviceGetAttribute(&cus, hipDeviceAttributeMultiprocessorCount, dev) != hipSuccess) { grid = -1; return; }
        if (hipFuncSetAttribute((const void*)hymba_fwd, hipFuncAttributeMaxDynamicSharedMemorySize, LDS_BYTES) != hipSuccess) { fprintf(stderr, "kernel_launch: hipFuncSetAttribute failed\n"); grid = -1; return; }
        if (hipOccupancyMaxActiveBlocksPerMultiprocessor(&per_cu, (const void*)hymba_fwd, NWAVES * 64, LDS_BYTES) != hipSuccess || per_cu < 1)
            fprintf(stderr, "kernel_launch: note: occupancy query reports %d workgroups per CU\n", per_cu);
        (void)hipGetLastError();
        grid = cus;
    }
    if (grid < 0) return;
    if (hipMemsetAsync((char*)d_ws + WS_CTL, 0, CTL_ZERO_BYTES, stream) != hipSuccess) return;
    Args a{};
    for (int i = 0; i < 24; ++i) a.in[i] = d_in[i];
    a.out = (float*)d_out; a.ws = (unsigned char*)d_ws;
    hipLaunchKernelGGL(hymba_fwd, dim3(grid), dim3(NWAVES * 64), LDS_BYTES, stream, a);
    const hipError_t le = hipPeekAtLastError();
    if (le != hipSuccess) fprintf(stderr, "kernel_launch: launch failed: %s\n", hipGetErrorName(le));
}
```
